# Optimizing an MI355X kernel written in HIP

```python
import jax
import jax.numpy as jnp
from jax import lax
import numpy as np

D_MODEL = 1024
BATCH = 4
SEQ = 4096
DEPTH = 4

D_FF = 4 * D_MODEL
NORM_EPS = 1e-6
L2_EPS = 1e-6

RET_HEADS = 4
RET_DK = D_MODEL // 8
RET_DV = D_MODEL // 8
RET_CHUNK = 128
ROPE_BASE = 10000.0

SSD_HEADS = 8
SSD_HEAD_DIM = D_MODEL // 16
SSD_GROUPS = 2
SSD_STATE = 128
SSD_CONV = 4
SSD_CHUNK = 128
DT_MIN = 1e-3
DT_MAX = 1e-1

GDN_HEADS = 4
GDN_DK = D_MODEL // 8
GDN_DV = D_MODEL // 8
GDN_CONV = 4
GDN_CHUNK = 64

RET_QK = RET_HEADS * RET_DK
RET_V = RET_HEADS * RET_DV
SSD_D = SSD_HEADS * SSD_HEAD_DIM
SSD_BC = SSD_GROUPS * SSD_STATE
SSD_XBC = SSD_D + 2 * SSD_BC
GDN_QK = GDN_HEADS * GDN_DK
GDN_V = GDN_HEADS * GDN_DV
GDN_QKV = 2 * GDN_QK + GDN_V
MIX_WIDTH = RET_V + SSD_D + GDN_V
IN_SPLITS = (RET_QK, RET_QK, RET_V, RET_V, SSD_D, SSD_XBC, SSD_HEADS, GDN_QKV, GDN_V, GDN_HEADS, GDN_HEADS)
D_IN = sum(IN_SPLITS)

kernel_name = 'hybrid_retention_ssd_gdn_trunk'

F32 = jnp.float32


def _split_offsets():
    offs, acc = [], 0
    for size in IN_SPLITS[:-1]:
        acc += size
        offs.append(acc)
    return offs


def _rms(t, eps=NORM_EPS):
    t = t.astype(F32)
    return t * lax.rsqrt(jnp.mean(t * t, axis=-1, keepdims=True) + eps)


def _rms_norm(x, w):
    return (_rms(x) * w).astype(x.dtype)


def _l2norm(t):
    return t * lax.rsqrt(jnp.sum(t * t, axis=-1, keepdims=True) + L2_EPS)


def _causal_conv(t, w):
    k = w.shape[0]
    return lax.conv_general_dilated(
        t, w[:, None, :].astype(t.dtype), (1,), [(k - 1, 0)],
        dimension_numbers=('NWC', 'WIO', 'NWC'), feature_group_count=t.shape[-1])


def _rotary(t, positions):
    half = t.shape[-1] // 2
    inv_freq = ROPE_BASE ** (-jnp.arange(half, dtype=F32) / half)
    ang = positions.astype(F32)[:, :, None] * inv_freq
    cos = jnp.cos(ang)[:, :, None, :]
    sin = jnp.sin(ang)[:, :, None, :]
    t1, t2 = t[..., :half], t[..., half:]
    return jnp.concatenate([t1 * cos - t2 * sin, t2 * cos + t1 * sin], axis=-1)


def _to_chunks(t, c):
    b, s, h, d = t.shape
    return t.reshape(b, s // c, c, h, d).transpose(0, 3, 1, 2, 4)


def _from_chunks(t):
    b, h, n, c, d = t.shape
    return t.transpose(0, 2, 3, 1, 4).reshape(b, n * c, h, d)


def _prev_chunk_states(decay, inc):
    def step(state, xs):
        d, i = xs
        return d * state + i, state
    _, prev = lax.scan(step, jnp.zeros_like(inc[0]), (decay, inc))
    return prev


def _retention(q, k, v, positions):
    c = RET_CHUNK
    dk = q.shape[-1]
    q = _rotary(q.astype(F32), positions) * (dk ** -0.5)
    k = _rotary(k.astype(F32), positions)
    q, k, v = (_to_chunks(t, c) for t in (q, k, v.astype(F32)))
    h, n = q.shape[1], q.shape[2]
    log_gamma = jnp.log1p(-jnp.exp2(-5.0 - jnp.arange(h, dtype=F32)))
    idx = jnp.arange(c, dtype=F32)
    rel = idx[:, None] - idx[None, :]
    causal = rel >= 0
    d_intra = jnp.where(causal, jnp.exp(log_gamma[:, None, None] * jnp.where(causal, rel, 0.0)), 0.0)
    scores = jnp.einsum('bhncd,bhnmd->bhncm', q, k) * d_intra[None, :, None]
    y = jnp.einsum('bhncm,bhnme->bhnce', scores, v)
    zeta = jnp.exp(log_gamma[:, None] * (c - 1 - idx))
    kv = jnp.einsum('bhnmd,hm,bhnme->nbhde', k, zeta, v)
    chunk_decay = jnp.broadcast_to(jnp.exp(log_gamma * c)[None, None, :, None, None], (n, 1, h, 1, 1))
    prev = _prev_chunk_states(chunk_decay, kv)
    xi = jnp.exp(log_gamma[:, None] * (idx + 1))
    y = y + jnp.einsum('bhncd,nbhde,hc->bhnce', q, prev, xi)
    return _from_chunks(y)


def _retention_mixer(q, k, v, gate, positions, norm_w):
    b, s, _ = q.shape
    y = _retention(q.reshape(b, s, RET_HEADS, RET_DK), k.reshape(b, s, RET_HEADS, RET_DK),
                   v.reshape(b, s, RET_HEADS, RET_DV), positions)
    y = _rms(y) * norm_w.reshape(RET_HEADS, RET_DV)
    return y.reshape(b, s, RET_V) * jax.nn.silu(gate.astype(F32))


def _ssd_mixer(z, xbc, dt_raw, conv_w, conv_b, dt_bias, a_log, d_skip, norm_w):
    b, s, _ = xbc.shape
    l = SSD_CHUNK
    n = s // l
    g = SSD_GROUPS
    r = SSD_HEADS // g
    p = SSD_HEAD_DIM
    ks = SSD_STATE
    xbc = jax.nn.silu((_causal_conv(xbc, conv_w) + conv_b).astype(F32))
    xs, bm, cm = jnp.split(xbc, [SSD_D, SSD_D + SSD_BC], axis=-1)
    xs = xs.reshape(b, n, l, g, r, p)
    bm = bm.reshape(b, n, l, g, ks)
    cm = cm.reshape(b, n, l, g, ks)
    dt = jax.nn.softplus(dt_raw.astype(F32) + dt_bias).reshape(b, n, l, g, r)
    a = -jnp.exp(a_log.astype(F32)).reshape(g, r)
    a_cs = jnp.cumsum(dt * a, axis=2)
    causal = jnp.tril(jnp.ones((l, l), bool))[None, None, :, :, None, None]
    seg = a_cs[:, :, :, None] - a_cs[:, :, None, :]
    decay = jnp.where(causal, jnp.exp(jnp.where(causal, seg, 0.0)), 0.0)
    xdt = xs * dt[..., None]
    cb = jnp.einsum('bnlgk,bnmgk->bnlmg', cm, bm)
    y = jnp.einsum('bnlmg,bnlmgr,bnmgrp->bnlgrp', cb, decay, xdt)
    to_end = jnp.exp(a_cs[:, :, -1:] - a_cs)
    states = jnp.einsum('bnmgk,bnmgr,bnmgrp->nbgrpk', bm, to_end, xdt)
    chunk_decay = jnp.exp(a_cs[:, :, -1]).transpose(1, 0, 2, 3)[..., None, None]
    prev = _prev_chunk_states(chunk_decay, states)
    y = y + jnp.einsum('bnlgk,nbgrpk,bnlgr->bnlgrp', cm, prev, jnp.exp(a_cs))
    y = y + xs * d_skip.astype(F32).reshape(g, r)[:, :, None]
    gsz = SSD_D // g
    y = y.reshape(b, s, g, gsz) * jax.nn.silu(z.astype(F32)).reshape(b, s, g, gsz)
    return _rms(y).reshape(b, s, SSD_D) * norm_w


def _gated_delta_net(qkv, z, b_raw, a_raw, conv_w, dt_bias, a_log, norm_w):
    b, s, _ = qkv.shape
    h, dk, dv, c = GDN_HEADS, GDN_DK, GDN_DV, GDN_CHUNK
    qkv = jax.nn.silu(_causal_conv(qkv, conv_w).astype(F32))
    q, k, v = jnp.split(qkv, [GDN_QK, 2 * GDN_QK], axis=-1)
    q = _l2norm(q.reshape(b, s, h, dk)) * (dk ** -0.5)
    k = _l2norm(k.reshape(b, s, h, dk))
    v = v.reshape(b, s, h, dv)
    beta = jax.nn.sigmoid(b_raw.astype(F32))[..., None]
    g = -jnp.exp(a_log.astype(F32)) * jax.nn.softplus(a_raw.astype(F32) + dt_bias)
    q, k, v, kb, vb = (_to_chunks(t, c) for t in (q, k, v, k * beta, v * beta))
    g_cs = jnp.cumsum(_to_chunks(g[..., None], c)[..., 0], axis=-1)
    incl = jnp.tril(jnp.ones((c, c), bool))
    strict = jnp.tril(jnp.ones((c, c), bool), -1)
    diff = g_cs[..., :, None] - g_cs[..., None, :]
    decay = jnp.where(incl, jnp.exp(jnp.where(incl, diff, 0.0)), 0.0)
    lower = jnp.where(strict, jnp.einsum('bhncd,bhnmd->bhncm', kb, k) * decay, 0.0)
    rhs = jnp.concatenate([vb, kb * jnp.exp(g_cs)[..., None]], axis=-1)
    sol = lax.linalg.triangular_solve(lower + jnp.eye(c, dtype=F32), rhs,
                                      left_side=True, lower=True, unit_diagonal=True)
    u, w = sol[..., :dv], sol[..., dv:]
    attn = jnp.einsum('bhncd,bhnmd->bhncm', q, k) * decay
    g_last = g_cs[..., -1:]
    q_dec = q * jnp.exp(g_cs)[..., None]
    k_dec = k * jnp.exp(g_last - g_cs)[..., None]
    chunk_decay = jnp.exp(g_last)[..., None]

    def step(state, xs):
        qd, kd, u_n, w_n, a_n, dec = xs
        v_new = u_n - jnp.einsum('bhck,bhkv->bhcv', w_n, state)
        o = jnp.einsum('bhck,bhkv->bhcv', qd, state) + jnp.einsum('bhcm,bhmv->bhcv', a_n, v_new)
        state = state * dec + jnp.einsum('bhck,bhcv->bhkv', kd, v_new)
        return state, o

    xs = tuple(jnp.moveaxis(t, 2, 0) for t in (q_dec, k_dec, u, w, attn, chunk_decay))
    _, o = lax.scan(step, jnp.zeros((b, h, dk, dv), F32), xs)
    o = _from_chunks(jnp.moveaxis(o, 0, 2))
    o = _rms(o) * norm_w * jax.nn.silu(z.astype(F32)).reshape(b, s, h, dv)
    return o.reshape(b, s, GDN_V)


def setup_inputs(seed: int = 0) -> dict:
    key = jax.random.key(seed)
    ks = jax.random.split(key, 24)

    def nrm(k, shape, scale):
        return scale * jax.random.normal(k, shape, F32)

    def gain(k, shape):
        return 1.0 + 0.02 * jax.random.normal(k, shape, F32)

    def dt_bias(k, shape):
        dt = jnp.exp(jax.random.uniform(k, shape, F32, jnp.log(DT_MIN), jnp.log(DT_MAX)))
        return dt + jnp.log(-jnp.expm1(-dt))

    def a_log(k, shape):
        return jnp.log(jax.random.uniform(k, shape, F32, 1.0, 16.0))

    x = jax.random.normal(ks[0], (BATCH, SEQ, D_MODEL), F32)
    offset = jax.random.randint(ks[1], (BATCH, 1), 0, 2048, jnp.int32)
    positions = offset + jnp.arange(SEQ, dtype=jnp.int32)[None, :]
    return {
        'x': x,
        'positions': positions,
        'mix_norm_w': gain(ks[2], (DEPTH, D_MODEL)),
        'w_in': nrm(ks[3], (DEPTH, D_MODEL, D_IN), D_MODEL ** -0.5),
        'ret_norm_w': gain(ks[4], (DEPTH, RET_V)),
        'ssd_conv_w': nrm(ks[5], (DEPTH, SSD_CONV, SSD_XBC), SSD_CONV ** -0.5),
        'ssd_conv_b': nrm(ks[6], (DEPTH, SSD_XBC), 0.02),
        'ssd_dt_bias': dt_bias(ks[7], (DEPTH, SSD_HEADS)),
        'ssd_a_log': a_log(ks[8], (DEPTH, SSD_HEADS)),
        'ssd_d': 1.0 + nrm(ks[9], (DEPTH, SSD_HEADS), 0.1),
        'ssd_norm_w': gain(ks[10], (DEPTH, SSD_D)),
        'gdn_conv_w': nrm(ks[11], (DEPTH, GDN_CONV, GDN_QKV), GDN_CONV ** -0.5),
        'gdn_dt_bias': dt_bias(ks[12], (DEPTH, GDN_HEADS)),
        'gdn_a_log': a_log(ks[13], (DEPTH, GDN_HEADS)),
        'gdn_norm_w': gain(ks[14], (DEPTH, GDN_DV)),
        'w_out': nrm(ks[15], (DEPTH, MIX_WIDTH, D_MODEL), MIX_WIDTH ** -0.5),
        'mlp_norm_w': gain(ks[16], (DEPTH, D_MODEL)),
        'w_up': nrm(ks[17], (DEPTH, D_MODEL, D_FF), D_MODEL ** -0.5),
        'w_down': nrm(ks[18], (DEPTH, D_FF, D_MODEL), D_FF ** -0.5),
        'final_norm_w': gain(ks[19], (D_MODEL,)),
    }


def reference(x, positions, mix_norm_w, w_in, ret_norm_w, ssd_conv_w, ssd_conv_b, ssd_dt_bias,
              ssd_a_log, ssd_d, ssd_norm_w, gdn_conv_w, gdn_dt_bias, gdn_a_log, gdn_norm_w,
              w_out, mlp_norm_w, w_up, w_down, final_norm_w):
    offsets = _split_offsets()
    for l in range(DEPTH):
        h = _rms_norm(x, mix_norm_w[l])
        rq, rk, rv, rg, sz, sxbc, sdt, gqkv, gz, gb, ga = jnp.split(h @ w_in[l], offsets, axis=-1)
        y_ret = _retention_mixer(rq, rk, rv, rg, positions, ret_norm_w[l])
        y_ssd = _ssd_mixer(sz, sxbc, sdt, ssd_conv_w[l], ssd_conv_b[l], ssd_dt_bias[l],
                           ssd_a_log[l], ssd_d[l], ssd_norm_w[l])
        y_gdn = _gated_delta_net(gqkv, gz, gb, ga, gdn_conv_w[l], gdn_dt_bias[l],
                                 gdn_a_log[l], gdn_norm_w[l])
        y = jnp.concatenate([y_ret, y_ssd, y_gdn], axis=-1).astype(x.dtype)
        x = x + y @ w_out[l]
        hm = _rms_norm(x, mlp_norm_w[l]) @ w_up[l]
        x = x + jnp.square(jax.nn.relu(hm)) @ w_down[l]
    return _rms_norm(x, final_norm_w)
```

```cpp
#include <hip/hip_runtime.h>
#include <cstdint>
#include <cstdio>

typedef unsigned short bf16_t;

constexpr int NB = 4, SEQ = 4096, DM = 1024, T = NB * SEQ, DEPTH = 4;
constexpr int DIN = 5648, NP = 5632, NSMALL = 16, DFF = 4096, MIXW = 1536;
constexpr float NORM_EPS = 1e-6f, L2_EPS = 1e-6f;
constexpr int C_RQ = 0, C_RK = 512, C_RG = 1024, C_SZ = 1536, C_SB = 2048, C_SC = 2304, C_GQ = 2560, C_GK = 3072, C_GZ = 3584,
              C_RV = 4096, C_SX = 4608, C_GV = 5120;
constexpr size_t MiB = 1u << 20;
constexpr size_t WS_CTL = 0;
constexpr size_t WS_SSA = 1 * MiB;
constexpr size_t WS_SSB = 2 * MiB;
constexpr size_t WS_SMALL = 3 * MiB;
constexpr size_t WS_COS = 4 * MiB, WS_SIN = 8 * MiB;
constexpr size_t WS_W = 12 * MiB;
constexpr size_t WSET = 31 * MiB;
constexpr size_t W_IN = 0, W_OUT = 12 * MiB, W_UP = 15 * MiB, W_DOWN = 23 * MiB;
constexpr size_t WS_XB = 74 * MiB;
constexpr size_t WS_PROJ = 106 * MiB;
constexpr size_t WS_END = 282 * MiB;

struct Params {
    const float* x; const int* pos; const float* mix_norm_w; const float* w_in; const float* ret_norm_w;
    const float* ssd_conv_w; const float* ssd_conv_b; const float* ssd_dt_bias; const float* ssd_a_log; const float* ssd_d; const float* ssd_norm_w;
    const float* gdn_conv_w; const float* gdn_dt_bias; const float* gdn_a_log; const float* gdn_norm_w;
    const float* w_out; const float* mlp_norm_w; const float* w_up; const float* w_down; const float* final_norm_w;
    float* out; unsigned char* ws;
};

__device__ __forceinline__ float bf2f(bf16_t v) { return __uint_as_float((unsigned)v << 16); }
__device__ __forceinline__ bf16_t f2bf(float f) { unsigned u = __float_as_uint(f); return (bf16_t)((u + 0x7fffu + ((u >> 16) & 1u)) >> 16); }
__device__ __forceinline__ float silu_f(float x) { return x / (1.f + __expf(-x)); }
__device__ __forceinline__ float sigmoid_f(float x) { return 1.f / (1.f + __expf(-x)); }
__device__ __forceinline__ float softplus_f(float x) { return fmaxf(x, 0.f) + log1pf(__expf(-fabsf(x))); }
__device__ __forceinline__ float row_rs(const float* ssp, int row) {
    const float4* p = (const float4*)(ssp + (size_t)row * 16); const float4 a = p[0], b = p[1], c = p[2], d = p[3];
    const float s = ((a.x + a.y) + (a.z + a.w)) + ((b.x + b.y) + (b.z + b.w)) + (((c.x + c.y) + (c.z + c.w)) + ((d.x + d.y) + (d.z + d.w)));
    return 1.0f / sqrtf(s * (1.f / DM) + NORM_EPS);
}

__host__ __device__ __forceinline__ int c_new2orig(int c) {
    if (c < 1024) return c;
    if (c < 1536) return c - 1024 + 1536;
    if (c < 2048) return c - 1536 + 2048;
    if (c < 2560) return c - 2048 + 3072;
    if (c < 3584) return c - 2560 + 3592;
    if (c < 4096) return c - 3584 + 5128;
    if (c < 4608) return c - 4096 + 1024;
    if (c < 5120) return c - 4608 + 2560;
    if (c < 5632) return c - 5120 + 4616;
    if (c < 5640) return c - 5632 + 3584;
    return c - 5640 + 5640;
}

__global__ void __launch_bounds__(256) k_p0(Params P) {
    float* cs = (float*)(P.ws + WS_COS); float* sn = (float*)(P.ws + WS_SIN);
    float* ss = (float*)(P.ws + WS_SSB); bf16_t* xb = (bf16_t*)(P.ws + WS_XB);
    const int gt = blockIdx.x * blockDim.x + threadIdx.x, ng = gridDim.x * blockDim.x;
    for (int i = gt; i < T * 64; i += ng) {
        const int row = i >> 6, f = i & 63;
        const float inv = exp2f(-(float)f * (13.287712379549449f / 64.f));
        const float ang = (float)P.pos[row] * inv;
        double rev = (double)ang * 0.15915494309189535; rev -= floor(rev);
        const float r = (float)rev;
        cs[i] = __builtin_amdgcn_cosf(r); sn[i] = __builtin_amdgcn_sinf(r);
    }
    const int gw = gt >> 6, nw = ng >> 6, lane = threadIdx.x & 63;
    for (int row = gw; row < T; row += nw) {
        const float* xr = P.x + (size_t)row * DM; float s = 0.f;
        for (int j = 0; j < DM / 64; ++j) { const float v = xr[j * 64 + lane]; s += v * v; xb[(size_t)row * DM + j * 64 + lane] = f2bf(v); }
        for (int o = 1; o < 64; o <<= 1) s += __shfl_xor(s, o);
        if (lane < 16) ss[(size_t)row * 16 + lane] = (lane == 0) ? s : 0.f;
    }
}

__global__ void __launch_bounds__(256) k_wconv(Params P, int layer) {
    unsigned char* wset = P.ws + WS_W + (size_t)(layer & 1) * WSET;
    bf16_t* WinT = (bf16_t*)(wset + W_IN); bf16_t* WoutT = (bf16_t*)(wset + W_OUT); bf16_t* WupT = (bf16_t*)(wset + W_UP); bf16_t* WdownT = (bf16_t*)(wset + W_DOWN);
    const size_t gt = (size_t)blockIdx.x * blockDim.x + threadIdx.x, ng = (size_t)gridDim.x * blockDim.x;
    const float* win = P.w_in + (size_t)layer * DM * DIN; const float* mnw = P.mix_norm_w + layer * DM;
    for (size_t i = gt; i < (size_t)DIN * DM; i += ng) { const int n = (int)(i / DM), k = (int)(i % DM); WinT[i] = f2bf(win[(size_t)k * DIN + c_new2orig(n)] * mnw[k]); }
    const float* wo = P.w_out + (size_t)layer * MIXW * DM;
    for (size_t i = gt; i < (size_t)DM * MIXW; i += ng) { const int n = (int)(i / MIXW), k = (int)(i % MIXW); WoutT[i] = f2bf(wo[(size_t)k * DM + n]); }
    const float* wu = P.w_up + (size_t)layer * DM * DFF; const float* lnw = P.mlp_norm_w + layer * DM;
    for (size_t i = gt; i < (size_t)DFF * DM; i += ng) { const int n = (int)(i / DM), k = (int)(i % DM); WupT[i] = f2bf(wu[(size_t)k * DFF + n] * lnw[k]); }
    const float* wd = P.w_down + (size_t)layer * DFF * DM;
    for (size_t i = gt; i < (size_t)DM * DFF; i += ng) { const int n = (int)(i / DFF), k = (int)(i % DFF); WdownT[i] = f2bf(wd[(size_t)k * DM + n]); }
}

enum { EPI_PROJ = 0, EPI_UP = 1, EPI_RES = 2 };
struct GemmArgs { const bf16_t* A; int lda; const bf16_t* Bt; int N, K; bf16_t* Ob; int ldc; const float* ss_in; const float* base; float* outx; bf16_t* xb; float* ss_out; };
template <int EPI> __global__ void __launch_bounds__(512) k_gemm_naive(GemmArgs g) {
    __shared__ float As[16][129]; __shared__ float Bs[16][65];
    const int tid = threadIdx.x, tm = tid >> 4, tn = tid & 15;
    const int ntn = g.N / 64; const int bm = blockIdx.x / ntn, bn = blockIdx.x % ntn;
    const int row0 = bm * 128, col0 = bn * 64;
    float acc[4][4] = {};
    for (int k0 = 0; k0 < g.K; k0 += 16) {
        { const int r = tid >> 2, kq = (tid & 3) * 4; const bf16_t* a = g.A + (size_t)(row0 + r) * g.lda + k0 + kq;
#pragma unroll
          for (int j = 0; j < 4; ++j) As[kq + j][r] = bf2f(a[j]); }
        { const int r = tid >> 3, kq = (tid & 7) * 2; const bf16_t* b = g.Bt + (size_t)(col0 + r) * g.K + k0 + kq;
#pragma unroll
          for (int j = 0; j < 2; ++j) Bs[kq + j][r] = bf2f(b[j]); }
        __syncthreads();
#pragma unroll
        for (int kk = 0; kk < 16; ++kk) { float a[4], b[4];
#pragma unroll
            for (int i = 0; i < 4; ++i) a[i] = As[kk][tm * 4 + i];
#pragma unroll
            for (int j = 0; j < 4; ++j) b[j] = Bs[kk][tn * 4 + j];
#pragma unroll
            for (int i = 0; i < 4; ++i)
#pragma unroll
                for (int j = 0; j < 4; ++j) acc[i][j] += a[i] * b[j]; }
        __syncthreads();
    }
#pragma unroll
    for (int i = 0; i < 4; ++i) { const int row = row0 + tm * 4 + i;
        float rs = 1.f; if (EPI != EPI_RES) rs = row_rs(g.ss_in, row);
        float sq = 0.f;
#pragma unroll
        for (int j = 0; j < 4; ++j) { const int col = col0 + tn * 4 + j; float v = acc[i][j];
            if (EPI == EPI_PROJ) g.Ob[(size_t)row * g.ldc + col] = f2bf(v * rs);
            else if (EPI == EPI_UP) { v = fmaxf(v * rs, 0.f); g.Ob[(size_t)row * g.ldc + col] = f2bf(v * v); }
            else { const float xn = g.base[(size_t)row * DM + col] + v; g.outx[(size_t)row * DM + col] = xn; g.xb[(size_t)row * DM + col] = f2bf(xn); sq += xn * xn; } }
        if (EPI == EPI_RES) { sq += __shfl_xor(sq, 1); sq += __shfl_xor(sq, 2); sq += __shfl_xor(sq, 4); sq += __shfl_xor(sq, 8); if (tn == 0) g.ss_out[(size_t)row * 16 + bn] = sq; }
    }
}

__global__ void __launch_bounds__(256) k_small(Params P, int layer) {
    const bf16_t* xb = (const bf16_t*)(P.ws + WS_XB); const bf16_t* W = (const bf16_t*)(P.ws + WS_W + (size_t)(layer & 1) * WSET + W_IN) + (size_t)NP * DM;
    const float* ss = (const float*)(P.ws + WS_SSB); float* sm = (float*)(P.ws + WS_SMALL);
    const int gt = blockIdx.x * blockDim.x + threadIdx.x, ng = gridDim.x * blockDim.x;
    for (int i = gt; i < T * 16; i += ng) { const int row = i >> 4, j = i & 15; float a = 0.f;
        for (int k = 0; k < DM; ++k) a += bf2f(xb[(size_t)row * DM + k]) * bf2f(W[(size_t)j * DM + k]);
        sm[i] = a * row_rs(ss, row); }
}

constexpr int TB = 8;
__device__ __forceinline__ void ret_naive(const Params& P, int layer, int prob, bool valid, int sub, int lt, float* lds) {
    bf16_t* proj = (bf16_t*)(P.ws + WS_PROJ); const float* cs = (const float*)(P.ws + WS_COS); const float* sn = (const float*)(P.ws + WS_SIN);
    const int b = prob >> 2, h = prob & 3, e = lt;
    float* qs = lds + sub * (3 * TB * 128 + 16); float* ks = qs + TB * 128; float* ys = ks + TB * 128; float* nrm = ys + TB * 128;
    const float gamma = 1.f - exp2f(-5.f - (float)h);
    const float nw = valid ? P.ret_norm_w[layer * 512 + h * 128 + e] : 0.f;
    float S[128];
#pragma unroll
    for (int d = 0; d < 128; ++d) S[d] = 0.f;
    for (int t0 = 0; t0 < SEQ; t0 += TB) {
        if (valid) {
            const int d = lt, i = d & 63;
#pragma unroll
            for (int tt = 0; tt < TB; ++tt) { const size_t row = (size_t)b * SEQ + t0 + tt; const bf16_t* pr = proj + row * NP;
                const float c = cs[row * 64 + i], s = sn[row * 64 + i];
                const float q1 = bf2f(pr[C_RQ + h * 128 + i]), q2 = bf2f(pr[C_RQ + h * 128 + 64 + i]);
                const float k1 = bf2f(pr[C_RK + h * 128 + i]), k2 = bf2f(pr[C_RK + h * 128 + 64 + i]);
                qs[tt * 128 + d] = ((d < 64) ? (q1 * c - q2 * s) : (q2 * c + q1 * s)) * 0.08838834764831845f;
                ks[tt * 128 + d] = (d < 64) ? (k1 * c - k2 * s) : (k2 * c + k1 * s); }
        }
        __syncthreads();
        if (valid) {
#pragma unroll 1
            for (int tt = 0; tt < TB; ++tt) { const size_t row = (size_t)b * SEQ + t0 + tt;
                const float v = bf2f(proj[row * NP + C_RV + h * 128 + e]); float y = 0.f;
#pragma unroll
                for (int d = 0; d < 128; ++d) { S[d] = gamma * S[d] + ks[tt * 128 + d] * v; y += qs[tt * 128 + d] * S[d]; }
                ys[tt * 128 + e] = y; }
        }
        __syncthreads();
        if (valid) { const int tt = lt >> 4, j0 = (lt & 15) * 8; float p = 0.f;
#pragma unroll
            for (int j = 0; j < 8; ++j) { const float v = ys[tt * 128 + j0 + j]; p += v * v; }
            p += __shfl_xor(p, 1); p += __shfl_xor(p, 2); p += __shfl_xor(p, 4); p += __shfl_xor(p, 8);
            if ((lt & 15) == 0) nrm[tt] = p; }
        __syncthreads();
        if (valid) {
#pragma unroll
            for (int tt = 0; tt < TB; ++tt) { const size_t row = (size_t)b * SEQ + t0 + tt;
                const float g = bf2f(proj[row * NP + C_RG + h * 128 + e]);
                const float o = ys[tt * 128 + e] * (1.0f / sqrtf(nrm[tt] * (1.f / 128.f) + NORM_EPS)) * nw * silu_f(g);
                proj[row * NP + C_RV + h * 128 + e] = f2bf(o); }
        }
    }
}
__device__ __forceinline__ void gdn_naive(const Params& P, int layer, int prob, bool valid, int sub, int lt, float* lds) {
    bf16_t* proj = (bf16_t*)(P.ws + WS_PROJ); const float* sm = (const float*)(P.ws + WS_SMALL);
    const int b = prob >> 2, h = prob & 3, e = lt;
    float* qs = lds + sub * (4 * TB * 128 + 16 + 4 * TB); float* ks = qs + TB * 128; float* ys = ks + TB * 128; float* vs = ys + TB * 128; float* nrm = vs + TB * 128; float* red = nrm + 16;
    const float* cw = P.gdn_conv_w + (size_t)layer * 4 * 1536;
    float wq[4], wk[4], wv[4];
#pragma unroll
    for (int j = 0; j < 4; ++j) { wq[j] = valid ? cw[j * 1536 + h * 128 + lt] : 0.f; wk[j] = valid ? cw[j * 1536 + 512 + h * 128 + lt] : 0.f; wv[j] = valid ? cw[j * 1536 + 1024 + h * 128 + lt] : 0.f; }
    const float nw = valid ? P.gdn_norm_w[layer * 128 + e] : 0.f;
    const float Aexp = valid ? __expf(P.gdn_a_log[layer * 4 + h]) : 0.f, dtb = valid ? P.gdn_dt_bias[layer * 4 + h] : 0.f;
    float S[128];
#pragma unroll
    for (int d = 0; d < 128; ++d) S[d] = 0.f;
    float q0 = 0.f, q1 = 0.f, q2 = 0.f, k0 = 0.f, k1 = 0.f, k2 = 0.f, v0 = 0.f, v1 = 0.f, v2 = 0.f;
    for (int t0 = 0; t0 < SEQ; t0 += TB) {
        if (valid) {
            float sq[TB], sk[TB];
#pragma unroll
            for (int tt = 0; tt < TB; ++tt) { const size_t row = (size_t)b * SEQ + t0 + tt; const bf16_t* pr = proj + row * NP;
                const float q3 = bf2f(pr[C_GQ + h * 128 + lt]), k3 = bf2f(pr[C_GK + h * 128 + lt]), v3 = bf2f(pr[C_GV + h * 128 + lt]);
                const float qc = silu_f(wq[0] * q0 + wq[1] * q1 + wq[2] * q2 + wq[3] * q3);
                const float kc = silu_f(wk[0] * k0 + wk[1] * k1 + wk[2] * k2 + wk[3] * k3);
                vs[tt * 128 + lt] = silu_f(wv[0] * v0 + wv[1] * v1 + wv[2] * v2 + wv[3] * v3);
                q0 = q1; q1 = q2; q2 = q3; k0 = k1; k1 = k2; k2 = k3; v0 = v1; v1 = v2; v2 = v3;
                qs[tt * 128 + lt] = qc; ks[tt * 128 + lt] = kc; sq[tt] = qc * qc; sk[tt] = kc * kc; }
#pragma unroll
            for (int tt = 0; tt < TB; ++tt) {
#pragma unroll
                for (int o = 1; o < 64; o <<= 1) { sq[tt] += __shfl_xor(sq[tt], o); sk[tt] += __shfl_xor(sk[tt], o); }
                if ((lt & 63) == 0) { red[((lt >> 6) * TB + tt) * 2] = sq[tt]; red[((lt >> 6) * TB + tt) * 2 + 1] = sk[tt]; } }
        }
        __syncthreads();
        if (valid) {
#pragma unroll 1
            for (int tt = 0; tt < TB; ++tt) { const size_t row = (size_t)b * SEQ + t0 + tt;
                const float rq = (1.0f / sqrtf(red[tt * 2] + red[(TB + tt) * 2] + L2_EPS)) * 0.08838834764831845f;
                const float rk = 1.0f / sqrtf(red[tt * 2 + 1] + red[(TB + tt) * 2 + 1] + L2_EPS);
                const float beta = sigmoid_f(sm[row * 16 + 8 + h]);
                const float g = -Aexp * softplus_f(sm[row * 16 + 12 + h] + dtb), alpha = __expf(g);
                float kS = 0.f;
#pragma unroll
                for (int d = 0; d < 128; ++d) kS += ks[tt * 128 + d] * S[d];
                const float vn = beta * (vs[tt * 128 + e] - alpha * kS * rk); const float vnk = vn * rk; float o = 0.f;
#pragma unroll
                for (int d = 0; d < 128; ++d) { S[d] = alpha * S[d] + ks[tt * 128 + d] * vnk; o += qs[tt * 128 + d] * S[d]; }
                ys[tt * 128 + e] = o * rq; }
        }
        __syncthreads();
        if (valid) { const int tt = lt >> 4, j0 = (lt & 15) * 8; float p = 0.f;
#pragma unroll
            for (int j = 0; j < 8; ++j) { const float v = ys[tt * 128 + j0 + j]; p += v * v; }
            p += __shfl_xor(p, 1); p += __shfl_xor(p, 2); p += __shfl_xor(p, 4); p += __shfl_xor(p, 8);
            if ((lt & 15) == 0) nrm[tt] = p; }
        __syncthreads();
        if (valid) {
#pragma unroll
            for (int tt = 0; tt < TB; ++tt) { const size_t row = (size_t)b * SEQ + t0 + tt;
                const float z = bf2f(proj[row * NP + C_GZ + h * 128 + e]);
                const float o = ys[tt * 128 + e] * (1.0f / sqrtf(nrm[tt] * (1.f / 128.f) + NORM_EPS)) * nw * silu_f(z);
                proj[row * NP + C_GV + h * 128 + e] = f2bf(o); }
        }
    }
}
__device__ __forceinline__ void ssd_naive(const Params& P, int layer, int prob, bool valid, int sub, int lt, float* lds) {
    bf16_t* proj = (bf16_t*)(P.ws + WS_PROJ); const float* sm = (const float*)(P.ws + WS_SMALL);
    const int b = prob >> 1, g = prob & 1, c = lt, h = 4 * g + (c >> 6);
    float* bc = lds + sub * (3 * TB * 256 + 16); float* ys = bc + TB * 256; float* xl = ys + TB * 256; float* nrm = xl + TB * 256;
    const float* cw = P.ssd_conv_w + (size_t)layer * 4 * 1024; const float* cb = P.ssd_conv_b + (size_t)layer * 1024;
    const int chx = g * 256 + c;
    const int chbc = (c < 128) ? (512 + g * 128 + c) : (768 + g * 128 + (c - 128));
    const int colbc = (c < 128) ? (C_SB + g * 128 + c) : (C_SC + g * 128 + (c - 128));
    float wx[4], wb[4];
#pragma unroll
    for (int j = 0; j < 4; ++j) { wx[j] = valid ? cw[j * 1024 + chx] : 0.f; wb[j] = valid ? cw[j * 1024 + chbc] : 0.f; }
    const float bx = valid ? cb[chx] : 0.f, bb = valid ? cb[chbc] : 0.f;
    const float a = valid ? -__expf(P.ssd_a_log[layer * 8 + h]) : 0.f, dtb = valid ? P.ssd_dt_bias[layer * 8 + h] : 0.f, dsk = valid ? P.ssd_d[layer * 8 + h] : 0.f;
    const float nw = valid ? P.ssd_norm_w[layer * 512 + g * 256 + c] : 0.f;
    float hs[128];
#pragma unroll
    for (int k = 0; k < 128; ++k) hs[k] = 0.f;
    float x0 = 0.f, x1 = 0.f, x2 = 0.f, b0 = 0.f, b1 = 0.f, b2 = 0.f;
    for (int t0 = 0; t0 < SEQ; t0 += TB) {
        if (valid) {
#pragma unroll
            for (int tt = 0; tt < TB; ++tt) { const size_t row = (size_t)b * SEQ + t0 + tt; const bf16_t* pr = proj + row * NP;
                const float x3 = bf2f(pr[C_SX + g * 256 + c]), b3 = bf2f(pr[colbc]);
                xl[tt * 256 + c] = silu_f(wx[0] * x0 + wx[1] * x1 + wx[2] * x2 + wx[3] * x3 + bx);
                bc[tt * 256 + c] = silu_f(wb[0] * b0 + wb[1] * b1 + wb[2] * b2 + wb[3] * b3 + bb);
                x0 = x1; x1 = x2; x2 = x3; b0 = b1; b1 = b2; b2 = b3; }
        }
        __syncthreads();
        if (valid) {
#pragma unroll 1
            for (int tt = 0; tt < TB; ++tt) { const size_t row = (size_t)b * SEQ + t0 + tt;
                const float xv = xl[tt * 256 + c]; const float dt = softplus_f(sm[row * 16 + h] + dtb), dA = __expf(dt * a), xd = dt * xv; float y = 0.f;
#pragma unroll
                for (int k = 0; k < 128; ++k) { hs[k] = dA * hs[k] + xd * bc[tt * 256 + k]; y += hs[k] * bc[tt * 256 + 128 + k]; }
                y += dsk * xv;
                const float z = bf2f(proj[row * NP + C_SZ + g * 256 + c]);
                ys[tt * 256 + c] = y * silu_f(z); }
        }
        __syncthreads();
        if (valid) { const int tt = lt >> 5, j0 = (lt & 31) * 8; float p = 0.f;
#pragma unroll
            for (int j = 0; j < 8; ++j) { const float v = ys[tt * 256 + j0 + j]; p += v * v; }
            p += __shfl_xor(p, 1); p += __shfl_xor(p, 2); p += __shfl_xor(p, 4); p += __shfl_xor(p, 8); p += __shfl_xor(p, 16);
            if ((lt & 31) == 0) nrm[tt] = p; }
        __syncthreads();
        if (valid) {
#pragma unroll
            for (int tt = 0; tt < TB; ++tt) { const size_t row = (size_t)b * SEQ + t0 + tt;
                const float o = ys[tt * 256 + c] * (1.0f / sqrtf(nrm[tt] * (1.f / 256.f) + NORM_EPS)) * nw;
                proj[row * NP + C_SX + g * 256 + c] = f2bf(o); }
        }
    }
}
__global__ void __launch_bounds__(128) k_ret_naive(Params P, int layer) { __shared__ float lds[3 * TB * 128 + 16]; ret_naive(P, layer, blockIdx.x, true, 0, threadIdx.x, lds); }
__global__ void __launch_bounds__(128) k_gdn_naive(Params P, int layer) { __shared__ float lds[4 * TB * 128 + 16 + 4 * TB]; gdn_naive(P, layer, blockIdx.x, true, 0, threadIdx.x, lds); }
__global__ void __launch_bounds__(256) k_ssd_naive(Params P, int layer) { __shared__ float lds[3 * TB * 256 + 16]; ssd_naive(P, layer, blockIdx.x, true, 0, threadIdx.x, lds); }

__global__ void __launch_bounds__(256) k_final(Params P) {
    const float* ss = (const float*)(P.ws + WS_SSB);
    const size_t gt = (size_t)blockIdx.x * blockDim.x + threadIdx.x, ng = (size_t)gridDim.x * blockDim.x;
    for (size_t i = gt; i < (size_t)T * DM; i += ng) { const int row = (int)(i >> 10), col = (int)(i & 1023);
        P.out[i] = P.out[i] * row_rs(ss, row) * P.final_norm_w[col]; }
}

extern "C" void kernel_launch(void* const* d_in, const int* in_sizes, int n_in, void* d_out, int out_size, void* d_ws, size_t ws_size, hipStream_t stream) {
    if (n_in != 20 || out_size != T * DM || ws_size < WS_END) { fprintf(stderr, "kernel_launch: unexpected shapes n_in=%d out=%d ws=%zu\n", n_in, out_size, ws_size); return; }
    Params P{};
    P.x = (const float*)d_in[0]; P.pos = (const int*)d_in[1]; P.mix_norm_w = (const float*)d_in[2]; P.w_in = (const float*)d_in[3]; P.ret_norm_w = (const float*)d_in[4];
    P.ssd_conv_w = (const float*)d_in[5]; P.ssd_conv_b = (const float*)d_in[6]; P.ssd_dt_bias = (const float*)d_in[7]; P.ssd_a_log = (const float*)d_in[8]; P.ssd_d = (const float*)d_in[9];
    P.ssd_norm_w = (const float*)d_in[10]; P.gdn_conv_w = (const float*)d_in[11]; P.gdn_dt_bias = (const float*)d_in[12]; P.gdn_a_log = (const float*)d_in[13]; P.gdn_norm_w = (const float*)d_in[14];
    P.w_out = (const float*)d_in[15]; P.mlp_norm_w = (const float*)d_in[16]; P.w_up = (const float*)d_in[17]; P.w_down = (const float*)d_in[18]; P.final_norm_w = (const float*)d_in[19];
    P.out = (float*)d_out; P.ws = (unsigned char*)d_ws;
    unsigned char* ws = P.ws;
    hipLaunchKernelGGL(k_p0, dim3(1024), dim3(256), 0, stream, P);
    for (int l = 0; l < DEPTH; ++l) {
        unsigned char* wset = ws + WS_W + (size_t)(l & 1) * WSET;
        float* ssa = (float*)(ws + WS_SSA); float* ssb = (float*)(ws + WS_SSB); bf16_t* xb = (bf16_t*)(ws + WS_XB); bf16_t* proj = (bf16_t*)(ws + WS_PROJ);
        hipLaunchKernelGGL(k_wconv, dim3(2048), dim3(256), 0, stream, P, l);
        { GemmArgs g{}; g.A = xb; g.lda = DM; g.Bt = (const bf16_t*)(wset + W_IN); g.N = NP; g.K = DM; g.Ob = proj; g.ldc = NP; g.ss_in = ssb;
          hipLaunchKernelGGL(k_gemm_naive<EPI_PROJ>, dim3((T / 128) * (NP / 64)), dim3(512), 0, stream, g); }
        hipLaunchKernelGGL(k_small, dim3(1024), dim3(256), 0, stream, P, l);
        hipLaunchKernelGGL(k_ret_naive, dim3(16), dim3(128), 0, stream, P, l);
        hipLaunchKernelGGL(k_gdn_naive, dim3(16), dim3(128), 0, stream, P, l);
        hipLaunchKernelGGL(k_ssd_naive, dim3(8), dim3(256), 0, stream, P, l);
        { GemmArgs g{}; g.A = proj + C_RV; g.lda = NP; g.Bt = (const bf16_t*)(wset + W_OUT); g.N = DM; g.K = MIXW; g.base = (l == 0) ? P.x : P.out; g.outx = P.out; g.xb = xb; g.ss_out = ssa;
          hipLaunchKernelGGL(k_gemm_naive<EPI_RES>, dim3((T / 128) * (DM / 64)), dim3(512), 0, stream, g); }
        { GemmArgs g{}; g.A = xb; g.lda = DM; g.Bt = (const bf16_t*)(wset + W_UP); g.N = DFF; g.K = DM; g.Ob = proj; g.ldc = DFF; g.ss_in = ssa;
          hipLaunchKernelGGL(k_gemm_naive<EPI_UP>, dim3((T / 128) * (DFF / 64)), dim3(512), 0, stream, g); }
        { GemmArgs g{}; g.A = proj; g.lda = DFF; g.Bt = (const bf16_t*)(wset + W_DOWN); g.N = DM; g.K = DFF; g.base = P.out; g.outx = P.out; g.xb = xb; g.ss_out = ssb;
          hipLaunchKernelGGL(k_gemm_naive<EPI_RES>, dim3((T / 128) * (DM / 64)), dim3(512), 0, stream, g); }
    }
    hipLaunchKernelGGL(k_final, dim3(2048), dim3(256), 0, stream, P);
}
```

```cpp
#include <hip/hip_runtime.h>
#include <hip/hip_cooperative_groups.h>
#include <cstdint>
#include <cstdio>
namespace cg = cooperative_groups;

typedef unsigned short bf16_t;

constexpr int NB = 4, SEQ = 4096, DM = 1024, T = NB * SEQ, DEPTH = 4;
constexpr int DIN = 5648, NP = 5632, NSMALL = 16, DFF = 4096, MIXW = 1536;
constexpr float NORM_EPS = 1e-6f, L2_EPS = 1e-6f;
constexpr int C_RQ = 0, C_RK = 512, C_RG = 1024, C_SZ = 1536, C_SB = 2048, C_SC = 2304, C_GQ = 2560, C_GK = 3072, C_GZ = 3584,
              C_RV = 4096, C_SX = 4608, C_GV = 5120;
constexpr size_t MiB = 1u << 20;
constexpr size_t WS_CTL = 0;
constexpr size_t WS_SSA = 1 * MiB;
constexpr size_t WS_SSB = 2 * MiB;
constexpr size_t WS_SMALL = 3 * MiB;
constexpr size_t WS_COS = 4 * MiB, WS_SIN = 8 * MiB;
constexpr size_t WS_W = 12 * MiB;
constexpr size_t WSET = 31 * MiB;
constexpr size_t W_IN = 0, W_OUT = 12 * MiB, W_UP = 15 * MiB, W_DOWN = 23 * MiB;
constexpr size_t WS_XB = 74 * MiB;
constexpr size_t WS_PROJ = 106 * MiB;
constexpr size_t WS_END = 282 * MiB;

struct Params {
    const float* x; const int* pos; const float* mix_norm_w; const float* w_in; const float* ret_norm_w;
    const float* ssd_conv_w; const float* ssd_conv_b; const float* ssd_dt_bias; const float* ssd_a_log; const float* ssd_d; const float* ssd_norm_w;
    const float* gdn_conv_w; const float* gdn_dt_bias; const float* gdn_a_log; const float* gdn_norm_w;
    const float* w_out; const float* mlp_norm_w; const float* w_up; const float* w_down; const float* final_norm_w;
    float* out; unsigned char* ws;
};

__device__ __forceinline__ float bf2f(bf16_t v) { return __uint_as_float((unsigned)v << 16); }
__device__ __forceinline__ bf16_t f2bf(float f) { unsigned u = __float_as_uint(f); return (bf16_t)((u + 0x7fffu + ((u >> 16) & 1u)) >> 16); }
__device__ __forceinline__ float silu_f(float x) { return x / (1.f + __expf(-x)); }
__device__ __forceinline__ float sigmoid_f(float x) { return 1.f / (1.f + __expf(-x)); }
__device__ __forceinline__ float softplus_f(float x) { return fmaxf(x, 0.f) + log1pf(__expf(-fabsf(x))); }
__device__ __forceinline__ float row_rs(const float* ssp, int row) {
    const float4* p = (const float4*)(ssp + (size_t)row * 16); const float4 a = p[0], b = p[1], c = p[2], d = p[3];
    const float s = ((a.x + a.y) + (a.z + a.w)) + ((b.x + b.y) + (b.z + b.w)) + (((c.x + c.y) + (c.z + c.w)) + ((d.x + d.y) + (d.z + d.w)));
    return 1.0f / sqrtf(s * (1.f / DM) + NORM_EPS);
}

__host__ __device__ __forceinline__ int c_new2orig(int c) {
    if (c < 1024) return c;
    if (c < 1536) return c - 1024 + 1536;
    if (c < 2048) return c - 1536 + 2048;
    if (c < 2560) return c - 2048 + 3072;
    if (c < 3584) return c - 2560 + 3592;
    if (c < 4096) return c - 3584 + 5128;
    if (c < 4608) return c - 4096 + 1024;
    if (c < 5120) return c - 4608 + 2560;
    if (c < 5632) return c - 5120 + 4616;
    if (c < 5640) return c - 5632 + 3584;
    return c - 5640 + 5640;
}


namespace pg8 {
#define PG8_LAS __attribute__((address_space(3)))
typedef unsigned short bf16_t;
typedef short bf16x8 __attribute__((ext_vector_type(8)));
typedef float f32x4 __attribute__((ext_vector_type(4)));
typedef unsigned u32x4 __attribute__((ext_vector_type(4)));
constexpr int BM = 256, BK = 64, HALF = 128, HTB = HALF * BK * 2  , STAGE_BYTES = 8 * HTB, NXCD = 8, WGM = 8;

__host__ __device__ __forceinline__ int lds_byte(int r, int c) { const int st = (r >> 4) * 2 + (c >> 5), rr = r & 15, cc = c & 31, ob = rr * 64 + cc * 2; return st * 1024 + (ob ^ (((ob >> 9) & 1) << 5)); }
__host__ __device__ __forceinline__ void stage_rc(int b, int& R, int& C) { const int st = b / 1024, sb = b % 1024, swz = sb ^ (((sb >> 9) & 1) << 5); R = (st >> 1) * 16 + swz / 64; C = (st & 1) * 32 + (swz % 64) / 2; }
__host__ __device__ __forceinline__ int perm32(int rho) { const int n = rho >> 4, i = rho & 15; return 8 * (i >> 2) + 4 * n + (i & 3); }

struct Unit { int pm, pn; };
struct Gemm { const bf16_t* A; const bf16_t* Bt; int M, N, K, lda; };

struct StaticOrder {
    int nM, nN, nwg, G, c;
    __host__ __device__ void init(int M, int N, int G_, int c_) { nM = M / BM; nN = N / BM; nwg = nM * nN; G = G_; c = c_; }
    __host__ __device__ bool next(int i, Unit& u) const {
        const long L = (long)i * G + c; if (L >= nwg) return false;
        int wgid = (int)L; { const int q = nwg / NXCD, r = nwg % NXCD, xcd = wgid % NXCD, off = wgid / NXCD; wgid = (xcd < r ? xcd * (q + 1) : r * (q + 1) + (xcd - r) * q) + off; }
        const int nig = WGM * nN, gid = wgid / nig, fm = gid * WGM, gsz = (nM - fm) < WGM ? (nM - fm) : WGM;
        u.pm = fm + ((wgid % nig) % gsz); u.pn = (wgid % nig) / gsz; return true;
    }
    __device__ __forceinline__ void a_ready(const Unit&) const {}
    __device__ __forceinline__ void done(const Unit&) const {}
};

__device__ __forceinline__ unsigned cvt_pk_bf16(float lo, float hi) { unsigned r; asm volatile("v_cvt_pk_bf16_f32 %0, %1, %2" : "=v"(r) : "v"(lo), "v"(hi)); return r; }
typedef float f32x2 __attribute__((ext_vector_type(2)));
template <class Epi, class Sched, bool ALIGN_EPI = false, bool SP2 = false>
__device__ __forceinline__ void gemm_phase(PG8_LAS unsigned char* lds, const Gemm g, const Sched& S, const Epi& E) {
    int tid_l = threadIdx.x; asm volatile("" : "+v"(tid_l));
    const int tid = tid_l, wid = __builtin_amdgcn_readfirstlane(tid >> 6), lane = tid & 63, wr = wid >> 2, wc = wid & 3, fr = lane & 15, fq = lane >> 4;
    const int K = g.K, nt = K / BK;
    unsigned voffA[2], voffB[2];
#pragma unroll
    for (int i = 0; i < 2; ++i) { int R, C; stage_rc(tid * 16 + i * 8192, R, C); const int Rb = Epi::PERM ? ((R & ~31) + perm32(R & 31)) : R;
        voffA[i] = (unsigned)(R * g.lda + C) * 2u; voffB[i] = (unsigned)(Rb * K + C) * 2u; }
    const size_t kstep = (size_t)(BK * 2);
    const size_t hstepA = (size_t)HALF * g.lda * 2, hstepB = (size_t)HALF * K * 2;
    const size_t tstepA = 2 * hstepA, tstepB = 2 * hstepB;
    const unsigned ldsw = (unsigned)wid * 1024u;
    const int aoff = lds_byte(wr * 64 + fr, fq * 8), boff = lds_byte(wc * 32 + fr, fq * 8);
#define PG8_SA(b, h) (((b) * 2 + (h)) * HTB)
#define PG8_SB(b, h) ((4 + (b) * 2 + (h)) * HTB)
#define PG8_STAGE(bufoff, gbase, voff) do { _Pragma("unroll") for (int _i = 0; _i < 2; ++_i) \
        __builtin_amdgcn_global_load_lds((const unsigned*)((const char*)(gbase) + (voff)[_i]), (PG8_LAS unsigned*)(lds + (bufoff) + ldsw + _i * 8192), 16, 0, 0); } while (0)
#define PG8_LDA(dst, b, h) do { _Pragma("unroll") for (int m = 0; m < 4; ++m) _Pragma("unroll") for (int k = 0; k < 2; ++k) dst[m][k] = *(const PG8_LAS bf16x8*)(lds + PG8_SA(b, h) + aoff + m * 2048 + k * 1024); } while (0)
#define PG8_LDB(dst, b, h) do { _Pragma("unroll") for (int n = 0; n < 2; ++n) _Pragma("unroll") for (int k = 0; k < 2; ++k) dst[n][k] = *(const PG8_LAS bf16x8*)(lds + PG8_SB(b, h) + boff + n * 2048 + k * 1024); } while (0)
#define PG8_MMA(ai, bj, At, Bt) do { __builtin_amdgcn_s_setprio(1); _Pragma("unroll") for (int m = 0; m < 4; ++m) _Pragma("unroll") for (int n = 0; n < 2; ++n) _Pragma("unroll") for (int k = 0; k < 2; ++k) \
        acc[ai][bj][m][n] = __builtin_amdgcn_mfma_f32_16x16x32_bf16(Bt[n][k], At[m][k], acc[ai][bj][m][n], 0, 0, 0); __builtin_amdgcn_s_setprio(0); } while (0)
#define PG8_WAIT_V(n) asm volatile("s_waitcnt vmcnt(" #n ")" ::: "memory")
#define PG8_WAIT_L(n) asm volatile("s_waitcnt lgkmcnt(" #n ")" ::: "memory")
#define PG8_BAR __builtin_amdgcn_s_barrier()
#define PG8_SCHED __builtin_amdgcn_sched_barrier(0)
    Unit cur, nxt; int ui = 0;
    if (!S.next(0, cur)) return;
    f32x4 acc[2][2][4][2];
#pragma unroll
    for (int a = 0; a < 2; ++a)
#pragma unroll
        for (int b = 0; b < 2; ++b)
#pragma unroll
            for (int m = 0; m < 4; ++m)
#pragma unroll
                for (int n = 0; n < 2; ++n) acc[a][b][m][n] = (f32x4){0.f, 0.f, 0.f, 0.f};
    bf16x8 At[4][2], B0[2][2], B1[2][2];
    const char* cA = (const char*)g.A + (size_t)cur.pm * tstepA; const char* cB = (const char*)g.Bt + (size_t)cur.pn * tstepB;
    S.a_ready(cur);
    if constexpr (SP2) {
        PG8_STAGE(PG8_SB(0, 0), cB, voffB); PG8_STAGE(PG8_SB(0, 1), cB + hstepB, voffB); PG8_STAGE(PG8_SA(0, 0), cA, voffA); PG8_STAGE(PG8_SA(0, 1), cA + hstepA, voffA);
        if (wr == 1) PG8_BAR;
        PG8_WAIT_V(2); PG8_BAR;
        PG8_STAGE(PG8_SB(1, 0), cB + kstep, voffB); PG8_STAGE(PG8_SA(1, 0), cA + kstep, voffA); PG8_STAGE(PG8_SB(1, 1), cB + hstepB + kstep, voffB);
        PG8_WAIT_V(6); PG8_BAR;
    } else {
        PG8_STAGE(PG8_SB(0, 0), cB, voffB); PG8_STAGE(PG8_SA(0, 0), cA, voffA); PG8_STAGE(PG8_SB(0, 1), cB + hstepB, voffB); PG8_STAGE(PG8_SA(0, 1), cA + hstepA, voffA);
        if (wr == 1) PG8_BAR;
        PG8_WAIT_V(4); PG8_BAR;
        PG8_STAGE(PG8_SB(1, 0), cB + kstep, voffB); PG8_STAGE(PG8_SA(1, 0), cA + kstep, voffA); PG8_STAGE(PG8_SB(1, 1), cB + hstepB + kstep, voffB);
        PG8_WAIT_V(6); PG8_BAR;
    }
    for (;;) {
        const bool has_next = S.next(ui + 1, nxt);
        const char* nA = has_next ? (const char*)g.A + (size_t)nxt.pm * tstepA : cA; const char* nB = has_next ? (const char*)g.Bt + (size_t)nxt.pn * tstepB : cB;
        for (int t = 0; t < nt; t += 2) {
            const bool last = (t == nt - 2);
            const char* a1 = cA + (size_t)(t + 1) * kstep;
            const char* a2 = last ? nA : cA + (size_t)(t + 2) * kstep; const char* b2 = last ? nB : cB + (size_t)(t + 2) * kstep;
            const char* a3 = a2 + kstep; const char* b3 = b2 + kstep;
            if (last && has_next) S.a_ready(nxt);
            if constexpr (SP2) {
            PG8_LDB(B0, 0, 0); PG8_LDB(B1, 0, 1); PG8_SCHED; PG8_LDA(At, 0, 0); PG8_STAGE(PG8_SA(1, 1), a1 + hstepA, voffA);
            PG8_WAIT_V(8); PG8_WAIT_L(0); PG8_BAR; PG8_MMA(0, 0, At, B0); PG8_MMA(0, 1, At, B1); PG8_BAR; PG8_SCHED;
            PG8_LDA(At, 0, 1); PG8_STAGE(PG8_SB(0, 0), b2, voffB); PG8_STAGE(PG8_SB(0, 1), b2 + hstepB, voffB); PG8_STAGE(PG8_SA(0, 0), a2, voffA);
            PG8_WAIT_V(8); PG8_WAIT_L(0); PG8_BAR; PG8_MMA(1, 0, At, B0); PG8_MMA(1, 1, At, B1); PG8_BAR; PG8_SCHED;
            PG8_LDB(B0, 1, 0); PG8_LDB(B1, 1, 1); PG8_SCHED; PG8_LDA(At, 1, 0); PG8_STAGE(PG8_SA(0, 1), a2 + hstepA, voffA);
            PG8_WAIT_V(8); PG8_WAIT_L(0); PG8_BAR; PG8_MMA(0, 0, At, B0); PG8_MMA(0, 1, At, B1); PG8_BAR; PG8_SCHED;
            PG8_LDA(At, 1, 1); PG8_STAGE(PG8_SB(1, 0), b3, voffB); PG8_STAGE(PG8_SB(1, 1), b3 + hstepB, voffB); PG8_STAGE(PG8_SA(1, 0), a3, voffA);
            PG8_WAIT_V(8); PG8_WAIT_L(0); PG8_BAR; PG8_MMA(1, 0, At, B0); PG8_MMA(1, 1, At, B1); PG8_BAR; PG8_SCHED;
            } else {
            PG8_LDB(B0, 0, 0); PG8_SCHED; PG8_LDA(At, 0, 0); PG8_STAGE(PG8_SA(1, 1), a1 + hstepA, voffA);
            PG8_WAIT_L(8); PG8_BAR; PG8_WAIT_L(0); PG8_MMA(0, 0, At, B0); PG8_BAR; PG8_SCHED;
            PG8_LDB(B1, 0, 1); PG8_STAGE(PG8_SB(0, 0), b2, voffB);
            PG8_BAR; PG8_WAIT_L(0); PG8_MMA(0, 1, At, B1); PG8_BAR;
            PG8_LDA(At, 0, 1); PG8_STAGE(PG8_SA(0, 0), a2, voffA);
            PG8_BAR; PG8_WAIT_L(0); PG8_MMA(1, 0, At, B0); PG8_BAR; PG8_SCHED;
            PG8_STAGE(PG8_SB(0, 1), b2 + hstepB, voffB);
            PG8_WAIT_V(6); PG8_BAR; PG8_MMA(1, 1, At, B1); PG8_BAR;
            PG8_LDB(B0, 1, 0); PG8_SCHED; PG8_LDA(At, 1, 0); PG8_STAGE(PG8_SA(0, 1), a2 + hstepA, voffA);
            PG8_WAIT_L(8); PG8_BAR; PG8_WAIT_L(0); PG8_MMA(0, 0, At, B0); PG8_BAR; PG8_SCHED;
            PG8_LDB(B1, 1, 1); PG8_STAGE(PG8_SB(1, 0), b3, voffB);
            PG8_BAR; PG8_WAIT_L(0); PG8_MMA(0, 1, At, B1); PG8_BAR;
            PG8_LDA(At, 1, 1); PG8_STAGE(PG8_SA(1, 0), a3, voffA);
            PG8_BAR; PG8_WAIT_L(0); PG8_MMA(1, 0, At, B0); PG8_BAR; PG8_SCHED;
            PG8_STAGE(PG8_SB(1, 1), b3 + hstepB, voffB);
            PG8_WAIT_V(6); PG8_BAR; PG8_MMA(1, 1, At, B1); PG8_BAR;
            }
        }
        if constexpr (ALIGN_EPI) { if (wr == 0) PG8_BAR; }
        if constexpr (!Epi::AFTER_DRAIN) { E(acc, cur, wr, wc, fr, fq); S.done(cur); }
        if (!has_next) break;
#pragma unroll
        for (int a = 0; a < 2; ++a)
#pragma unroll
            for (int b = 0; b < 2; ++b)
#pragma unroll
                for (int m = 0; m < 4; ++m)
#pragma unroll
                    for (int n = 0; n < 2; ++n) acc[a][b][m][n] = (f32x4){0.f, 0.f, 0.f, 0.f};
        cur = nxt; cA = nA; cB = nB; ++ui;
        if constexpr (ALIGN_EPI) { if (wr == 1) PG8_BAR; }
    }
    PG8_WAIT_V(0);
    if constexpr (!ALIGN_EPI) { if (wr == 0) PG8_BAR; }
    PG8_BAR;
    if constexpr (Epi::AFTER_DRAIN) { E.fused(acc, cur, wr, wc, fr, fq, lds, wid, lane); S.done(cur); }
#undef PG8_SA
#undef PG8_SB
#undef PG8_STAGE
#undef PG8_LDA
#undef PG8_LDB
#undef PG8_MMA
#undef PG8_WAIT_V
#undef PG8_WAIT_L
#undef PG8_BAR
#undef PG8_SCHED
}
}

namespace pg8 {
template <int ACT> struct EpiScaleBf16 {
    static constexpr bool PERM = true, AFTER_DRAIN = false;
    bf16_t* O; int ldc; const float* ssp;
    __device__ __forceinline__ void operator()(const f32x4 (&acc)[2][2][4][2], const Unit& u, int wr, int wc, int fr, int fq) const {
        const int row0 = u.pm * BM + wr * 64 + fr, col0 = u.pn * BM + wc * 32 + 8 * fq;
#pragma unroll
        for (int ai = 0; ai < 2; ++ai)
#pragma unroll
            for (int m = 0; m < 4; ++m) { const int row = row0 + ai * HALF + m * 16; const float rs = row_rs(ssp, row); bf16_t* rowp = O + (size_t)row * ldc + col0;
#pragma unroll
                for (int bj = 0; bj < 2; ++bj) { f32x4 v0 = acc[ai][bj][m][0] * rs, v1 = acc[ai][bj][m][1] * rs;
                    if (ACT == 1) {
#pragma unroll
                        for (int i = 0; i < 4; ++i) { const float a = fmaxf(v0[i], 0.f), b = fmaxf(v1[i], 0.f); v0[i] = a * a; v1[i] = b * b; } }
                    u32x4 w; w.x = cvt_pk_bf16(v0[0], v0[1]); w.y = cvt_pk_bf16(v0[2], v0[3]); w.z = cvt_pk_bf16(v1[0], v1[1]); w.w = cvt_pk_bf16(v1[2], v1[3]);
                    *(u32x4*)(rowp + bj * HALF) = w; } }
    }
};
struct EpiRes {
    static constexpr bool PERM = false, AFTER_DRAIN = false;
    const float* base; float* outx; bf16_t* xb; float* ss_out;
    __device__ __forceinline__ void operator()(const f32x4 (&acc)[2][2][4][2], const Unit& u, int wr, int wc, int fr, int fq) const {
        typedef unsigned u32x2v __attribute__((ext_vector_type(2)));
        const int row0 = u.pm * BM + wr * 64 + fr, col0 = u.pn * BM + wc * 32 + 4 * fq;
#pragma unroll
        for (int ai = 0; ai < 2; ++ai)
#pragma unroll
            for (int m = 0; m < 4; ++m) { const int row = row0 + ai * HALF + m * 16; const size_t off = (size_t)row * DM + col0; float sq = 0.f;
#pragma unroll
                for (int bj = 0; bj < 2; ++bj)
#pragma unroll
                    for (int n = 0; n < 2; ++n) { const size_t o = off + bj * HALF + n * 16; const f32x4 xn = *(const f32x4*)(base + o) + acc[ai][bj][m][n];
                        *(f32x4*)(outx + o) = xn; u32x2v w; w.x = cvt_pk_bf16(xn[0], xn[1]); w.y = cvt_pk_bf16(xn[2], xn[3]); *(u32x2v*)(xb + o) = w;
                        sq += (xn[0] * xn[0] + xn[1] * xn[1]) + (xn[2] * xn[2] + xn[3] * xn[3]); }
                sq += __shfl_xor(sq, 16); sq += __shfl_xor(sq, 32);
                if (fq == 0) ss_out[(size_t)row * 16 + u.pn * 4 + wc] = sq; }
    }
};
}

#define GAS __attribute__((address_space(1)))
#define LAS __attribute__((address_space(3)))
constexpr int NWAVES = 8;
constexpr int RING_OFF = 0, RING_BYTES = 131072;
constexpr int LDSCTL_OFF = RING_BYTES, MISC_OFF = LDSCTL_OFF + 320;
constexpr int LDS_BYTES = 147456;
constexpr int CW_BAR = 4096;
constexpr size_t CTL_ZERO_BYTES = 64 * 1024;
typedef unsigned v4u __attribute__((ext_vector_type(4)));
#define LDS_WAIT() asm volatile("s_waitcnt lgkmcnt(0)" ::: "memory")
__device__ __forceinline__ unsigned pk2(float lo, float hi) { return (unsigned)f2bf(lo) | ((unsigned)f2bf(hi) << 16); }
#define XB_TMO      128
#define XB_XCNT(j)  (256  + 64 * (j))
#define XB_XSUB(j)  (1280 + 64 * (j))
#define XB_XGEN(j)  (2304 + 64 * (j))
#define XB_TOP      3328
#define XB_TOPGEN   3392
#define XCD_BAR_WORDS 3456
#define XB_SPIN_CAP (1u << 18)

__device__ __forceinline__ unsigned xb_ld(unsigned* p)              { return __hip_atomic_load(p, __ATOMIC_RELAXED, __HIP_MEMORY_SCOPE_AGENT); }
__device__ __forceinline__ unsigned xb_add(unsigned* p, unsigned v) { return __hip_atomic_fetch_add(p, v, __ATOMIC_RELAXED, __HIP_MEMORY_SCOPE_AGENT); }
__device__ __forceinline__ unsigned xb_xcc_id() { return (unsigned)__builtin_amdgcn_s_getreg((3 << 11) | 20) & 0xFu; }
#define XB_SPIN(cond, bar) do { unsigned _sp = 0; while (cond) { __builtin_amdgcn_s_sleep(1); \
    if ((++_sp & 255u) == 0u) { if (xb_ld(&(bar)[XB_TMO])) break; if (_sp > XB_SPIN_CAP) { atomicAdd(&(bar)[XB_TMO], 1u); break; } } } } while (0)

struct XcdBarrier {
    unsigned* bar; unsigned x;
    volatile LAS unsigned* st;
};

__device__ __forceinline__ XcdBarrier xcd_barrier_post(unsigned* bar, volatile LAS unsigned* st) {
    XcdBarrier b; b.bar = bar; b.x = xb_xcc_id(); b.st = st;
    if (threadIdx.x == 0) (void)xb_add(&bar[XB_XCNT(b.x)], 1u);
    return b;
}
__device__ __forceinline__ void xcd_barrier_complete(unsigned* bar, unsigned x, unsigned& nloc, unsigned& nx) {
    const unsigned G = gridDim.x * gridDim.y * gridDim.z;
    unsigned sum, cnt, mine, sp = 0u;
    for (;;) {
        sum = 0u; cnt = 0u; mine = 0u;
#pragma unroll
        for (unsigned j = 0; j < 16; ++j) { const unsigned c = xb_ld(&bar[XB_XCNT(j)]); sum += c; cnt += (c > 0u) ? 1u : 0u; mine = (j == x) ? c : mine; }
        if (sum == G) break;
        __builtin_amdgcn_s_sleep(1);
        if ((++sp & 255u) == 0u) { if (xb_ld(&bar[XB_TMO])) break; if (sp > XB_SPIN_CAP) { atomicAdd(&bar[XB_TMO], 1u); break; } }
    }
    nloc = mine > 0u ? mine : 1u; nx = cnt > 0u ? cnt : 1u;
}

__device__ __forceinline__ void xcd_barrier(const XcdBarrier& b) {
    asm volatile("s_waitcnt vmcnt(0)" ::: "memory");
    __syncthreads();
    if (threadIdx.x == 0) {
        unsigned* bar = b.bar;
        __builtin_amdgcn_s_waitcnt(0);
        unsigned nloc = b.st[0], nx = b.st[1];
        if (nloc == 0u) { xcd_barrier_complete(bar, b.x, nloc, nx); b.st[0] = nloc; b.st[1] = nx; }
        const unsigned old = xb_add(&bar[XB_XSUB(b.x)], 1u);
        const unsigned gen = old / nloc;
        if (old + 1u == (gen + 1u) * nloc) {
            __builtin_amdgcn_fence(__ATOMIC_RELEASE, "agent");
            asm volatile("s_waitcnt vmcnt(0)" ::: "memory");
            const unsigned og = xb_add(&bar[XB_TOP], 1u);
            const unsigned tg = og / nx;
            if (og + 1u == (tg + 1u) * nx) xb_add(&bar[XB_TOPGEN], 1u);
            else XB_SPIN(xb_ld(&bar[XB_TOPGEN]) == tg, bar);
            __builtin_amdgcn_fence(__ATOMIC_ACQUIRE, "agent");
            xb_add(&bar[XB_XGEN(b.x)], 1u);
            asm volatile("s_waitcnt vmcnt(0)" ::: "memory");
        } else {
            XB_SPIN(xb_ld(&bar[XB_XGEN(b.x)]) == gen, bar);
            __builtin_amdgcn_fence(__ATOMIC_ACQUIRE, "agent");
            asm volatile("s_waitcnt vmcnt(0)" ::: "memory");
        }
    }
    __syncthreads();
}

template <bool MAPIN> __device__ __forceinline__ void transpose_item(const float* W, int K, int Nsrc, int Ndst, const float* kscale, bf16_t* WT, LAS float* scr, int item, int lane) {
    const int nblk = (Ndst + 31) / 32, kb = item / nblk, nb = item % nblk, k0 = 64 * kb, n0 = 32 * nb;
    const int nn = n0 + (lane & 31); const bool ok = nn < Ndst; const int sc = MAPIN ? c_new2orig(ok ? nn : 0) : nn;
#pragma unroll 8
    for (int i = 0; i < 32; ++i) { const int kk = 2 * i + (lane >> 5); float v = ok ? W[(size_t)(k0 + kk) * Nsrc + sc] : 0.f; if (kscale) v *= kscale[k0 + kk]; scr[kk * 33 + (lane & 31)] = v; }
    LDS_WAIT(); asm volatile("" ::: "memory");
    const int c = lane & 7;
#pragma unroll
    for (int j = 0; j < 4; ++j) { const int n = (lane >> 3) + 8 * j; const LAS float* s = scr + (8 * c) * 33 + n;
        v4u o; o.x = pk2(s[0 * 33], s[1 * 33]); o.y = pk2(s[2 * 33], s[3 * 33]); o.z = pk2(s[4 * 33], s[5 * 33]); o.w = pk2(s[6 * 33], s[7 * 33]);
        if (n0 + n < Ndst) *(v4u*)(WT + (size_t)(n0 + n) * K + k0 + 8 * c) = o; }
    LDS_WAIT(); asm volatile("" ::: "memory");
}
__device__ __forceinline__ void convert_layer_weights(const Params& P, int layer, LAS float* scr, int gw, int NGW, int lane) {
    unsigned char* wset = P.ws + WS_W + (size_t)(layer & 1) * WSET;
    constexpr int I_IN = (DM / 64) * ((DIN + 31) / 32), I_OUT = (MIXW / 64) * (DM / 32), I_UP = (DM / 64) * (DFF / 32), I_DN = (DFF / 64) * (DM / 32);
    for (int it = gw; it < I_IN + I_OUT + I_UP + I_DN; it += NGW) {
        int r = it;
        if (r < I_IN) { transpose_item<true>(P.w_in + (size_t)layer * DM * DIN, DM, DIN, DIN, P.mix_norm_w + layer * DM, (bf16_t*)(wset + W_IN), scr, r, lane); continue; } r -= I_IN;
        if (r < I_OUT) { transpose_item<false>(P.w_out + (size_t)layer * MIXW * DM, MIXW, DM, DM, nullptr, (bf16_t*)(wset + W_OUT), scr, r, lane); continue; } r -= I_OUT;
        if (r < I_UP) { transpose_item<false>(P.w_up + (size_t)layer * DM * DFF, DM, DFF, DFF, P.mlp_norm_w + layer * DM, (bf16_t*)(wset + W_UP), scr, r, lane); continue; } r -= I_UP;
        transpose_item<false>(P.w_down + (size_t)layer * DFF * DM, DFF, DM, DM, nullptr, (bf16_t*)(wset + W_DOWN), scr, r, lane);
    }
}
constexpr int TB = 8;
__device__ __forceinline__ void ret_naive(const Params& P, int layer, int prob, bool valid, int sub, int lt, float* lds) {
    bf16_t* proj = (bf16_t*)(P.ws + WS_PROJ); const float* cs = (const float*)(P.ws + WS_COS); const float* sn = (const float*)(P.ws + WS_SIN);
    const int b = prob >> 2, h = prob & 3, e = lt;
    float* qs = lds + sub * (3 * TB * 128 + 16); float* ks = qs + TB * 128; float* ys = ks + TB * 128; float* nrm = ys + TB * 128;
    const float gamma = 1.f - exp2f(-5.f - (float)h);
    const float nw = valid ? P.ret_norm_w[layer * 512 + h * 128 + e] : 0.f;
    float S[128];
#pragma unroll
    for (int d = 0; d < 128; ++d) S[d] = 0.f;
    for (int t0 = 0; t0 < SEQ; t0 += TB) {
        if (valid) {
            const int d = lt, i = d & 63;
#pragma unroll
            for (int tt = 0; tt < TB; ++tt) { const size_t row = (size_t)b * SEQ + t0 + tt; const bf16_t* pr = proj + row * NP;
                const float c = cs[row * 64 + i], s = sn[row * 64 + i];
                const float q1 = bf2f(pr[C_RQ + h * 128 + i]), q2 = bf2f(pr[C_RQ + h * 128 + 64 + i]);
                const float k1 = bf2f(pr[C_RK + h * 128 + i]), k2 = bf2f(pr[C_RK + h * 128 + 64 + i]);
                qs[tt * 128 + d] = ((d < 64) ? (q1 * c - q2 * s) : (q2 * c + q1 * s)) * 0.08838834764831845f;
                ks[tt * 128 + d] = (d < 64) ? (k1 * c - k2 * s) : (k2 * c + k1 * s); }
        }
        __syncthreads();
        if (valid) {
#pragma unroll 1
            for (int tt = 0; tt < TB; ++tt) { const size_t row = (size_t)b * SEQ + t0 + tt;
                const float v = bf2f(proj[row * NP + C_RV + h * 128 + e]); float y = 0.f;
#pragma unroll
                for (int d = 0; d < 128; ++d) { S[d] = gamma * S[d] + ks[tt * 128 + d] * v; y += qs[tt * 128 + d] * S[d]; }
                ys[tt * 128 + e] = y; }
        }
        __syncthreads();
        if (valid) { const int tt = lt >> 4, j0 = (lt & 15) * 8; float p = 0.f;
#pragma unroll
            for (int j = 0; j < 8; ++j) { const float v = ys[tt * 128 + j0 + j]; p += v * v; }
            p += __shfl_xor(p, 1); p += __shfl_xor(p, 2); p += __shfl_xor(p, 4); p += __shfl_xor(p, 8);
            if ((lt & 15) == 0) nrm[tt] = p; }
        __syncthreads();
        if (valid) {
#pragma unroll
            for (int tt = 0; tt < TB; ++tt) { const size_t row = (size_t)b * SEQ + t0 + tt;
                const float g = bf2f(proj[row * NP + C_RG + h * 128 + e]);
                const float o = ys[tt * 128 + e] * (1.0f / sqrtf(nrm[tt] * (1.f / 128.f) + NORM_EPS)) * nw * silu_f(g);
                proj[row * NP + C_RV + h * 128 + e] = f2bf(o); }
        }
    }
}
__device__ __forceinline__ void gdn_naive(const Params& P, int layer, int prob, bool valid, int sub, int lt, float* lds) {
    bf16_t* proj = (bf16_t*)(P.ws + WS_PROJ); const float* sm = (const float*)(P.ws + WS_SMALL);
    const int b = prob >> 2, h = prob & 3, e = lt;
    float* qs = lds + sub * (4 * TB * 128 + 16 + 4 * TB); float* ks = qs + TB * 128; float* ys = ks + TB * 128; float* vs = ys + TB * 128; float* nrm = vs + TB * 128; float* red = nrm + 16;
    const float* cw = P.gdn_conv_w + (size_t)layer * 4 * 1536;
    float wq[4], wk[4], wv[4];
#pragma unroll
    for (int j = 0; j < 4; ++j) { wq[j] = valid ? cw[j * 1536 + h * 128 + lt] : 0.f; wk[j] = valid ? cw[j * 1536 + 512 + h * 128 + lt] : 0.f; wv[j] = valid ? cw[j * 1536 + 1024 + h * 128 + lt] : 0.f; }
    const float nw = valid ? P.gdn_norm_w[layer * 128 + e] : 0.f;
    const float Aexp = valid ? __expf(P.gdn_a_log[layer * 4 + h]) : 0.f, dtb = valid ? P.gdn_dt_bias[layer * 4 + h] : 0.f;
    float S[128];
#pragma unroll
    for (int d = 0; d < 128; ++d) S[d] = 0.f;
    float q0 = 0.f, q1 = 0.f, q2 = 0.f, k0 = 0.f, k1 = 0.f, k2 = 0.f, v0 = 0.f, v1 = 0.f, v2 = 0.f;
    for (int t0 = 0; t0 < SEQ; t0 += TB) {
        if (valid) {
            float sq[TB], sk[TB];
#pragma unroll
            for (int tt = 0; tt < TB; ++tt) { const size_t row = (size_t)b * SEQ + t0 + tt; const bf16_t* pr = proj + row * NP;
                const float q3 = bf2f(pr[C_GQ + h * 128 + lt]), k3 = bf2f(pr[C_GK + h * 128 + lt]), v3 = bf2f(pr[C_GV + h * 128 + lt]);
                const float qc = silu_f(wq[0] * q0 + wq[1] * q1 + wq[2] * q2 + wq[3] * q3);
                const float kc = silu_f(wk[0] * k0 + wk[1] * k1 + wk[2] * k2 + wk[3] * k3);
                vs[tt * 128 + lt] = silu_f(wv[0] * v0 + wv[1] * v1 + wv[2] * v2 + wv[3] * v3);
                q0 = q1; q1 = q2; q2 = q3; k0 = k1; k1 = k2; k2 = k3; v0 = v1; v1 = v2; v2 = v3;
                qs[tt * 128 + lt] = qc; ks[tt * 128 + lt] = kc; sq[tt] = qc * qc; sk[tt] = kc * kc; }
#pragma unroll
            for (int tt = 0; tt < TB; ++tt) {
#pragma unroll
                for (int o = 1; o < 64; o <<= 1) { sq[tt] += __shfl_xor(sq[tt], o); sk[tt] += __shfl_xor(sk[tt], o); }
                if ((lt & 63) == 0) { red[((lt >> 6) * TB + tt) * 2] = sq[tt]; red[((lt >> 6) * TB + tt) * 2 + 1] = sk[tt]; } }
        }
        __syncthreads();
        if (valid) {
#pragma unroll 1
            for (int tt = 0; tt < TB; ++tt) { const size_t row = (size_t)b * SEQ + t0 + tt;
                const float rq = (1.0f / sqrtf(red[tt * 2] + red[(TB + tt) * 2] + L2_EPS)) * 0.08838834764831845f;
                const float rk = 1.0f / sqrtf(red[tt * 2 + 1] + red[(TB + tt) * 2 + 1] + L2_EPS);
                const float beta = sigmoid_f(sm[row * 16 + 8 + h]);
                const float g = -Aexp * softplus_f(sm[row * 16 + 12 + h] + dtb), alpha = __expf(g);
                float kS = 0.f;
#pragma unroll
                for (int d = 0; d < 128; ++d) kS += ks[tt * 128 + d] * S[d];
                const float vn = beta * (vs[tt * 128 + e] - alpha * kS * rk); const float vnk = vn * rk; float o = 0.f;
#pragma unroll
                for (int d = 0; d < 128; ++d) { S[d] = alpha * S[d] + ks[tt * 128 + d] * vnk; o += qs[tt * 128 + d] * S[d]; }
                ys[tt * 128 + e] = o * rq; }
        }
        __syncthreads();
        if (valid) { const int tt = lt >> 4, j0 = (lt & 15) * 8; float p = 0.f;
#pragma unroll
            for (int j = 0; j < 8; ++j) { const float v = ys[tt * 128 + j0 + j]; p += v * v; }
            p += __shfl_xor(p, 1); p += __shfl_xor(p, 2); p += __shfl_xor(p, 4); p += __shfl_xor(p, 8);
            if ((lt & 15) == 0) nrm[tt] = p; }
        __syncthreads();
        if (valid) {
#pragma unroll
            for (int tt = 0; tt < TB; ++tt) { const size_t row = (size_t)b * SEQ + t0 + tt;
                const float z = bf2f(proj[row * NP + C_GZ + h * 128 + e]);
                const float o = ys[tt * 128 + e] * (1.0f / sqrtf(nrm[tt] * (1.f / 128.f) + NORM_EPS)) * nw * silu_f(z);
                proj[row * NP + C_GV + h * 128 + e] = f2bf(o); }
        }
    }
}
__device__ __forceinline__ void ssd_naive(const Params& P, int layer, int prob, bool valid, int sub, int lt, float* lds) {
    bf16_t* proj = (bf16_t*)(P.ws + WS_PROJ); const float* sm = (const float*)(P.ws + WS_SMALL);
    const int b = prob >> 1, g = prob & 1, c = lt, h = 4 * g + (c >> 6);
    float* bc = lds + sub * (3 * TB * 256 + 16); float* ys = bc + TB * 256; float* xl = ys + TB * 256; float* nrm = xl + TB * 256;
    const float* cw = P.ssd_conv_w + (size_t)layer * 4 * 1024; const float* cb = P.ssd_conv_b + (size_t)layer * 1024;
    const int chx = g * 256 + c;
    const int chbc = (c < 128) ? (512 + g * 128 + c) : (768 + g * 128 + (c - 128));
    const int colbc = (c < 128) ? (C_SB + g * 128 + c) : (C_SC + g * 128 + (c - 128));
    float wx[4], wb[4];
#pragma unroll
    for (int j = 0; j < 4; ++j) { wx[j] = valid ? cw[j * 1024 + chx] : 0.f; wb[j] = valid ? cw[j * 1024 + chbc] : 0.f; }
    const float bx = valid ? cb[chx] : 0.f, bb = valid ? cb[chbc] : 0.f;
    const float a = valid ? -__expf(P.ssd_a_log[layer * 8 + h]) : 0.f, dtb = valid ? P.ssd_dt_bias[layer * 8 + h] : 0.f, dsk = valid ? P.ssd_d[layer * 8 + h] : 0.f;
    const float nw = valid ? P.ssd_norm_w[layer * 512 + g * 256 + c] : 0.f;
    float hs[128];
#pragma unroll
    for (int k = 0; k < 128; ++k) hs[k] = 0.f;
    float x0 = 0.f, x1 = 0.f, x2 = 0.f, b0 = 0.f, b1 = 0.f, b2 = 0.f;
    for (int t0 = 0; t0 < SEQ; t0 += TB) {
        if (valid) {
#pragma unroll
            for (int tt = 0; tt < TB; ++tt) { const size_t row = (size_t)b * SEQ + t0 + tt; const bf16_t* pr = proj + row * NP;
                const float x3 = bf2f(pr[C_SX + g * 256 + c]), b3 = bf2f(pr[colbc]);
                xl[tt * 256 + c] = silu_f(wx[0] * x0 + wx[1] * x1 + wx[2] * x2 + wx[3] * x3 + bx);
                bc[tt * 256 + c] = silu_f(wb[0] * b0 + wb[1] * b1 + wb[2] * b2 + wb[3] * b3 + bb);
                x0 = x1; x1 = x2; x2 = x3; b0 = b1; b1 = b2; b2 = b3; }
        }
        __syncthreads();
        if (valid) {
#pragma unroll 1
            for (int tt = 0; tt < TB; ++tt) { const size_t row = (size_t)b * SEQ + t0 + tt;
                const float xv = xl[tt * 256 + c]; const float dt = softplus_f(sm[row * 16 + h] + dtb), dA = __expf(dt * a), xd = dt * xv; float y = 0.f;
#pragma unroll
                for (int k = 0; k < 128; ++k) { hs[k] = dA * hs[k] + xd * bc[tt * 256 + k]; y += hs[k] * bc[tt * 256 + 128 + k]; }
                y += dsk * xv;
                const float z = bf2f(proj[row * NP + C_SZ + g * 256 + c]);
                ys[tt * 256 + c] = y * silu_f(z); }
        }
        __syncthreads();
        if (valid) { const int tt = lt >> 5, j0 = (lt & 31) * 8; float p = 0.f;
#pragma unroll
            for (int j = 0; j < 8; ++j) { const float v = ys[tt * 256 + j0 + j]; p += v * v; }
            p += __shfl_xor(p, 1); p += __shfl_xor(p, 2); p += __shfl_xor(p, 4); p += __shfl_xor(p, 8); p += __shfl_xor(p, 16);
            if ((lt & 31) == 0) nrm[tt] = p; }
        __syncthreads();
        if (valid) {
#pragma unroll
            for (int tt = 0; tt < TB; ++tt) { const size_t row = (size_t)b * SEQ + t0 + tt;
                const float o = ys[tt * 256 + c] * (1.0f / sqrtf(nrm[tt] * (1.f / 256.f) + NORM_EPS)) * nw;
                proj[row * NP + C_SX + g * 256 + c] = f2bf(o); }
        }
    }
}

struct Args { Params P; };
typedef const __attribute__((address_space(4))) Params* kparams_t;
__device__ __forceinline__ Params load_params() {
#if defined(__HIP_DEVICE_COMPILE__)
    kparams_t kp = (kparams_t)__builtin_amdgcn_kernarg_segment_ptr(); asm volatile("" : "+s"(kp));
    Params r; r.x = kp->x; r.pos = kp->pos; r.mix_norm_w = kp->mix_norm_w; r.w_in = kp->w_in; r.ret_norm_w = kp->ret_norm_w; r.ssd_conv_w = kp->ssd_conv_w; r.ssd_conv_b = kp->ssd_conv_b; r.ssd_dt_bias = kp->ssd_dt_bias;
    r.ssd_a_log = kp->ssd_a_log; r.ssd_d = kp->ssd_d; r.ssd_norm_w = kp->ssd_norm_w; r.gdn_conv_w = kp->gdn_conv_w; r.gdn_dt_bias = kp->gdn_dt_bias; r.gdn_a_log = kp->gdn_a_log; r.gdn_norm_w = kp->gdn_norm_w;
    r.w_out = kp->w_out; r.mlp_norm_w = kp->mlp_norm_w; r.w_up = kp->w_up; r.w_down = kp->w_down; r.final_norm_w = kp->final_norm_w; r.out = kp->out; r.ws = kp->ws; return r;
#else
    return Params{};
#endif
}
__global__ void __launch_bounds__(NWAVES * 64, 2) fwd_mega(Params Pk_unused) {
    extern __shared__ __attribute__((aligned(16))) unsigned char lds[];
    LAS unsigned char* L = (LAS unsigned char*)lds;
    const int tid = threadIdx.x, lane = tid & 63, wave = __builtin_amdgcn_readfirstlane(tid >> 6);
    const int G = gridDim.x, bx = blockIdx.x;
    const int vcu = (G % 8 == 0) ? (bx % 8) * (G / 8) + bx / 8 : bx;
    for (int u = tid; u < (LDS_BYTES - LDSCTL_OFF) / 4; u += NWAVES * 64) ((LAS unsigned*)(L + LDSCTL_OFF))[u] = 0u;
    __syncthreads();
    unsigned char* const wsb = load_params().ws;
    unsigned* ctl = (unsigned*)(wsb + WS_CTL);
    XcdBarrier bar = xcd_barrier_post(ctl + CW_BAR, (volatile LAS unsigned*)(L + MISC_OFF) + 8);
    cg::grid_group grid = cg::this_grid();
#define GRID_BAR() xcd_barrier(bar)
#define ssa ((float*)(P.ws + WS_SSA))
#define ssb ((float*)(P.ws + WS_SSB))
#define sm ((float*)(P.ws + WS_SMALL))
#define xb ((bf16_t*)(P.ws + WS_XB))
#define proj ((bf16_t*)(P.ws + WS_PROJ))
    const int gw = vcu * NWAVES + wave, NGW = G * NWAVES;
    LAS float* scr = (LAS float*)(L + RING_OFF + wave * 16384);

    {
        const Params P = load_params();
        float* cs = (float*)(P.ws + WS_COS); float* sn = (float*)(P.ws + WS_SIN);
        const int gt = bx * (NWAVES * 64) + tid, ng = G * NWAVES * 64;
        for (int i = gt; i < T * 64; i += ng) {
            const int row = i >> 6, f = i & 63;
            const float inv = exp2f(-(float)f * (13.287712379549449f / 64.f));
            const float ang = (float)P.pos[row] * inv;
            double rev = (double)ang * 0.15915494309189535; rev -= floor(rev);
            const float r = (float)rev;
            cs[i] = __builtin_amdgcn_cosf(r); sn[i] = __builtin_amdgcn_sinf(r);
        }
        for (int row = gw; row < T; row += NGW) {
            const float* xr = P.x + (size_t)row * DM; float s = 0.f;
#pragma unroll
            for (int j = 0; j < DM / 256; ++j) { const float4 v = *(const float4*)(xr + j * 256 + lane * 4); s += (v.x * v.x + v.y * v.y) + (v.z * v.z + v.w * v.w);
                uint2 w; w.x = pk2(v.x, v.y); w.y = pk2(v.z, v.w); *(uint2*)(xb + (size_t)row * DM + j * 256 + lane * 4) = w; }
#pragma unroll
            for (int o = 1; o < 64; o <<= 1) s += __shfl_xor(s, o);
            if (lane < 16) ssb[(size_t)row * 16 + lane] = (lane == 0) ? s : 0.f;
        }
        convert_layer_weights(P, 0, scr, gw, NGW, lane);
    }
    grid.sync();

    for (int l = 0; l < DEPTH; ++l) {
        {
            const Params P = load_params(); unsigned char* wset = P.ws + WS_W + (size_t)(l & 1) * WSET; (void)wset;
            pg8::Gemm g{xb, (const bf16_t*)(wset + W_IN), T, NP, DM, DM}; pg8::StaticOrder S; S.init(T, NP, G, bx);
            pg8::EpiScaleBf16<0> E{proj, NP, ssb};
            pg8::gemm_phase<pg8::EpiScaleBf16<0>, pg8::StaticOrder, true, true>(L + RING_OFF, g, S, E);
            const bf16_t* Ws = (const bf16_t*)(wset + W_IN) + (size_t)NP * DM;
            const int gt = bx * (NWAVES * 64) + tid, ng = G * NWAVES * 64;
            for (int i = gt; i < T * 16; i += ng) { const int row = i >> 4, j = i & 15; float a = 0.f;
                const uint4* xr = (const uint4*)(xb + (size_t)row * DM); const uint4* wr_ = (const uint4*)(Ws + (size_t)j * DM);
#pragma unroll 4
                for (int k = 0; k < DM / 8; ++k) { const uint4 xv = xr[k], wv = wr_[k];
                    a += __uint_as_float(xv.x << 16) * __uint_as_float(wv.x << 16) + __uint_as_float(xv.x & 0xffff0000u) * __uint_as_float(wv.x & 0xffff0000u);
                    a += __uint_as_float(xv.y << 16) * __uint_as_float(wv.y << 16) + __uint_as_float(xv.y & 0xffff0000u) * __uint_as_float(wv.y & 0xffff0000u);
                    a += __uint_as_float(xv.z << 16) * __uint_as_float(wv.z << 16) + __uint_as_float(xv.z & 0xffff0000u) * __uint_as_float(wv.z & 0xffff0000u);
                    a += __uint_as_float(xv.w << 16) * __uint_as_float(wv.w << 16) + __uint_as_float(xv.w & 0xffff0000u) * __uint_as_float(wv.w & 0xffff0000u); }
                sm[i] = a * row_rs(ssb, row); }
        }
        GRID_BAR();
        {
            const Params P = load_params(); unsigned char* wset = P.ws + WS_W + (size_t)(l & 1) * WSET; (void)wset;
            float* fl = (float*)lds;
            int tl = tid; asm volatile("" : "+v"(tl));
            const int sub128 = tl >> 7, sub256 = tl >> 8;
            if (bx < 16) ret_naive(P, l, bx, sub128 == 0, sub128, tl & 127, fl);
            else if (bx < 32) gdn_naive(P, l, bx - 16, sub128 == 0, sub128, tl & 127, fl);
            else if (bx < 40) ssd_naive(P, l, bx - 32, sub256 == 0, sub256, tl & 255, fl);
            else if (l + 1 < DEPTH) convert_layer_weights(P, l + 1, scr, (bx - 40) * NWAVES + wave, (G - 40) * NWAVES, lane);
        }
        GRID_BAR();
        {
            const Params P = load_params(); unsigned char* wset = P.ws + WS_W + (size_t)(l & 1) * WSET; (void)wset;
            pg8::Gemm g{proj + C_RV, (const bf16_t*)(wset + W_OUT), T, DM, MIXW, NP}; pg8::StaticOrder S; S.init(T, DM, G, bx);
            pg8::EpiRes E{(l == 0) ? P.x : (const float*)P.out, P.out, xb, ssa};
            pg8::gemm_phase<pg8::EpiRes, pg8::StaticOrder, true, true>(L + RING_OFF, g, S, E);
        }
        GRID_BAR();
        {
            const Params P = load_params(); unsigned char* wset = P.ws + WS_W + (size_t)(l & 1) * WSET; (void)wset;
            pg8::Gemm g{xb, (const bf16_t*)(wset + W_UP), T, DFF, DM, DM}; pg8::StaticOrder S; S.init(T, DFF, G, bx);
            pg8::EpiScaleBf16<1> E{proj, DFF, ssa};
            pg8::gemm_phase<pg8::EpiScaleBf16<1>, pg8::StaticOrder, true, true>(L + RING_OFF, g, S, E);
        }
        GRID_BAR();
        {
            const Params P = load_params(); unsigned char* wset = P.ws + WS_W + (size_t)(l & 1) * WSET; (void)wset;
            pg8::Gemm g{proj, (const bf16_t*)(wset + W_DOWN), T, DM, DFF, DFF}; pg8::StaticOrder S; S.init(T, DM, G, bx);
            pg8::EpiRes E{(const float*)P.out, P.out, xb, ssb};
            pg8::gemm_phase<pg8::EpiRes, pg8::StaticOrder, true, true>(L + RING_OFF, g, S, E);
        }
        GRID_BAR();
    }
    const Params P = load_params();
    for (int row = gw; row < T; row += NGW) {
        const float rs = row_rs(ssb, row); float* xr = P.out + (size_t)row * DM;
#pragma unroll
        for (int j = 0; j < DM / 256; ++j) { float4 v = *(float4*)(xr + j * 256 + lane * 4); const float4 w = *(const float4*)(P.final_norm_w + j * 256 + lane * 4);
            v.x *= rs * w.x; v.y *= rs * w.y; v.z *= rs * w.z; v.w *= rs * w.w; *(float4*)(xr + j * 256 + lane * 4) = v; }
    }
}

extern "C" void kernel_launch(void* const* d_in, const int* in_sizes, int n_in, void* d_out, int out_size, void* d_ws, size_t ws_size, hipStream_t stream) {
    static int grid = 0;
    if (grid == 0) {
        if (n_in != 20 || out_size != T * DM || ws_size < WS_END) { fprintf(stderr, "kernel_launch: unexpected shapes n_in=%d out=%d ws=%zu (need %zu)\n", n_in, out_size, ws_size, (size_t)WS_END); grid = -1; return; }
        int dev = 0, cus = 0, per_cu = 0;
        (void)hipGetDevice(&dev); (void)hipDeviceGetAttribute(&cus, hipDeviceAttributeMultiprocessorCount, dev);
        if (hipFuncSetAttribute((const void*)fwd_mega, hipFuncAttributeMaxDynamicSharedMemorySize, LDS_BYTES) != hipSuccess) { fprintf(stderr, "kernel_launch: hipFuncSetAttribute failed\n"); grid = -1; return; }
        if (hipOccupancyMaxActiveBlocksPerMultiprocessor(&per_cu, (const void*)fwd_mega, NWAVES * 64, LDS_BYTES) != hipSuccess || per_cu < 1) { fprintf(stderr, "kernel_launch: occupancy query says %d blocks/CU\n", per_cu); (void)hipGetLastError(); grid = -1; return; }
        grid = cus;
        if (grid % 8 != 0 || grid < 64) fprintf(stderr, "kernel_launch: note: %d CUs\n", grid);
    }
    if (grid < 0) return;
    Params P{};
    P.x = (const float*)d_in[0]; P.pos = (const int*)d_in[1]; P.mix_norm_w = (const float*)d_in[2]; P.w_in = (const float*)d_in[3]; P.ret_norm_w = (const float*)d_in[4];
    P.ssd_conv_w = (const float*)d_in[5]; P.ssd_conv_b = (const float*)d_in[6]; P.ssd_dt_bias = (const float*)d_in[7]; P.ssd_a_log = (const float*)d_in[8]; P.ssd_d = (const float*)d_in[9];
    P.ssd_norm_w = (const float*)d_in[10]; P.gdn_conv_w = (const float*)d_in[11]; P.gdn_dt_bias = (const float*)d_in[12]; P.gdn_a_log = (const float*)d_in[13]; P.gdn_norm_w = (const float*)d_in[14];
    P.w_out = (const float*)d_in[15]; P.mlp_norm_w = (const float*)d_in[16]; P.w_up = (const float*)d_in[17]; P.w_down = (const float*)d_in[18]; P.final_norm_w = (const float*)d_in[19];
    P.out = (float*)d_out; P.ws = (unsigned char*)d_ws;
    if (hipMemsetAsync((char*)d_ws + WS_CTL, 0, CTL_ZERO_BYTES, stream) != hipSuccess) { fprintf(stderr, "kernel_launch: memset failed\n"); return; }
    void* args[] = {&P};
    hipError_t e = hipLaunchCooperativeKernel((const void*)fwd_mega, dim3(grid), dim3(NWAVES * 64), args, LDS_BYTES, stream);
    if (e != hipSuccess) fprintf(stderr, "kernel_launch: cooperative launch failed: %s (grid %d)\n", hipGetErrorString(e), grid);
}
```

```cpp
#include <hip/hip_runtime.h>
#include <hip/hip_cooperative_groups.h>
#include <cstdint>
#include <cstdio>
namespace cg = cooperative_groups;

typedef unsigned short bf16_t;

constexpr int NB = 4, SEQ = 4096, DM = 1024, T = NB * SEQ, DEPTH = 4;
constexpr int DIN = 5648, NP = 5632, NPX = 5888, NSMALL = 16, DFF = 4096, MIXW = 1536;
constexpr float NORM_EPS = 1e-6f, L2_EPS = 1e-6f;
constexpr int C_RQ = 0, C_RK = 512, C_RG = 1024, C_SZ = 1536, C_SB = 2048, C_SC = 2304, C_GQ = 2560, C_GK = 3072, C_GZ = 3584,
              C_RV = 4096, C_SX = 4608, C_GV = 5120;
constexpr size_t MiB = 1u << 20;
constexpr size_t WS_CTL = 0;
constexpr size_t WS_SSA = 1 * MiB;
constexpr size_t WS_SSB = 2 * MiB;
constexpr size_t WS_SMALL = 3 * MiB;
constexpr size_t WS_COS = 4 * MiB, WS_SIN = 8 * MiB;
constexpr size_t WS_W = 12 * MiB;
constexpr size_t WSET = 31 * MiB;
constexpr size_t W_IN = 0, W_OUT = 12 * MiB, W_UP = 15 * MiB, W_DOWN = 23 * MiB;
constexpr size_t WS_XB = 74 * MiB;
constexpr size_t WS_YS = 90 * MiB;
constexpr size_t WS_PROJ = 106 * MiB;
constexpr size_t WS_GT = 282 * MiB;
constexpr size_t WS_HALO = 343 * MiB;
constexpr size_t WS_ACS = 345 * MiB;
constexpr size_t WS_END = 346 * MiB;

struct Params {
    const float* x; const int* pos; const float* mix_norm_w; const float* w_in; const float* ret_norm_w;
    const float* ssd_conv_w; const float* ssd_conv_b; const float* ssd_dt_bias; const float* ssd_a_log; const float* ssd_d; const float* ssd_norm_w;
    const float* gdn_conv_w; const float* gdn_dt_bias; const float* gdn_a_log; const float* gdn_norm_w;
    const float* w_out; const float* mlp_norm_w; const float* w_up; const float* w_down; const float* final_norm_w;
    float* out; unsigned char* ws;
};

__device__ __forceinline__ float bf2f(bf16_t v) { return __uint_as_float((unsigned)v << 16); }
typedef float f32x2_c __attribute__((ext_vector_type(2)));
typedef __bf16 bf16x2_c __attribute__((ext_vector_type(2)));
__device__ __forceinline__ unsigned pk2(float lo, float hi) { f32x2_c v; v.x = lo; v.y = hi; return __builtin_bit_cast(unsigned, __builtin_convertvector(v, bf16x2_c)); }
__device__ __forceinline__ bf16_t f2bf(float f) { return (bf16_t)(pk2(f, f) & 0xffffu); }
__device__ __forceinline__ float silu_f(float x) { return x * __builtin_amdgcn_rcpf(1.f + __expf(-x)); }
__device__ __forceinline__ float sigmoid_f(float x) { return __builtin_amdgcn_rcpf(1.f + __expf(-x)); }
__device__ __forceinline__ float rsqrt_f(float x) { return __builtin_amdgcn_rsqf(x); }
__device__ __forceinline__ float softplus_f(float x) { return fmaxf(x, 0.f) + log1pf(__expf(-fabsf(x))); }
__device__ __forceinline__ float row_rs(const float* ssp, int row) {
    const float4* p = (const float4*)(ssp + (size_t)row * 16); const float4 a = p[0], b = p[1], c = p[2], d = p[3];
    const float s = ((a.x + a.y) + (a.z + a.w)) + ((b.x + b.y) + (b.z + b.w)) + (((c.x + c.y) + (c.z + c.w)) + ((d.x + d.y) + (d.z + d.w)));
    return rsqrt_f(s * (1.f / DM) + NORM_EPS);
}

__host__ __device__ __forceinline__ int c_new2orig(int c) {
    if (c < 1024) return c;
    if (c < 1536) return c - 1024 + 1536;
    if (c < 2048) return c - 1536 + 2048;
    if (c < 2560) return c - 2048 + 3072;
    if (c < 3584) return c - 2560 + 3592;
    if (c < 4096) return c - 3584 + 5128;
    if (c < 4608) return c - 4096 + 1024;
    if (c < 5120) return c - 4608 + 2560;
    if (c < 5632) return c - 5120 + 4616;
    if (c < 5640) return c - 5632 + 3584;
    return c - 5640 + 5640;
}


namespace pg8 {
#define PG8_LAS __attribute__((address_space(3)))
typedef unsigned short bf16_t;
typedef short bf16x8 __attribute__((ext_vector_type(8)));
typedef float f32x4 __attribute__((ext_vector_type(4)));
typedef unsigned u32x4 __attribute__((ext_vector_type(4)));
constexpr int BM = 256, BK = 64, HALF = 128, HTB = HALF * BK * 2  , STAGE_BYTES = 8 * HTB, NXCD = 8, WGM = 4;

__host__ __device__ __forceinline__ int lds_byte(int r, int c) { const int st = (r >> 4) * 2 + (c >> 5), rr = r & 15, cc = c & 31, ob = rr * 64 + cc * 2; return st * 1024 + (ob ^ (((ob >> 9) & 1) << 5)); }
__host__ __device__ __forceinline__ void stage_rc(int b, int& R, int& C) { const int st = b / 1024, sb = b % 1024, swz = sb ^ (((sb >> 9) & 1) << 5); R = (st >> 1) * 16 + swz / 64; C = (st & 1) * 32 + (swz % 64) / 2; }
__host__ __device__ __forceinline__ int perm32(int rho) { const int n = rho >> 4, i = rho & 15; return 8 * (i >> 2) + 4 * n + (i & 3); }

struct Unit { int pm, pn; };
struct Gemm { const bf16_t* A; const bf16_t* Bt; int M, N, K, lda; };

struct StaticOrder {
    int nM, nN, nwg, G, c;
    __host__ __device__ void init(int M, int N, int G_, int c_) { nM = M / BM; nN = N / BM; nwg = nM * nN; G = G_; c = c_; }
    __host__ __device__ bool next(int i, Unit& u) const {
        const long L = (long)i * G + c; if (L >= nwg) return false;
        int wgid = (int)L; { const int q = nwg / NXCD, r = nwg % NXCD, xcd = wgid % NXCD, off = wgid / NXCD; wgid = (xcd < r ? xcd * (q + 1) : r * (q + 1) + (xcd - r) * q) + off; }
        const int nig = WGM * nN, gid = wgid / nig, fm = gid * WGM, gsz = (nM - fm) < WGM ? (nM - fm) : WGM;
        u.pm = fm + ((wgid % nig) % gsz); u.pn = (wgid % nig) / gsz; return true;
    }
    __device__ __forceinline__ void a_ready(const Unit&) const {}
    __device__ __forceinline__ void done(const Unit&) const {}
};

__device__ __forceinline__ unsigned cvt_pk_bf16(float lo, float hi) { unsigned r; asm volatile("v_cvt_pk_bf16_f32 %0, %1, %2" : "=v"(r) : "v"(lo), "v"(hi)); return r; }
typedef float f32x2 __attribute__((ext_vector_type(2)));
template <class Epi, class Sched, bool ALIGN_EPI = false, bool SP2 = false>
__device__ __forceinline__ void gemm_phase(PG8_LAS unsigned char* lds, const Gemm g, const Sched& S, const Epi& E) {
    int tid_l = threadIdx.x; asm volatile("" : "+v"(tid_l));
    const int tid = tid_l, wid = __builtin_amdgcn_readfirstlane(tid >> 6), lane = tid & 63, wr = wid >> 2, wc = wid & 3, fr = lane & 15, fq = lane >> 4;
    const int K = g.K, nt = K / BK;
    unsigned voffA[2], voffB[2];
#pragma unroll
    for (int i = 0; i < 2; ++i) { int R, C; stage_rc(tid * 16 + i * 8192, R, C); const int Rb = Epi::PERM ? ((R & ~31) + perm32(R & 31)) : R;
        voffA[i] = (unsigned)(R * g.lda + C) * 2u; voffB[i] = (unsigned)(Rb * K + C) * 2u; }
    const size_t kstep = (size_t)(BK * 2);
    const size_t hstepA = (size_t)HALF * g.lda * 2, hstepB = (size_t)HALF * K * 2;
    const size_t tstepA = 2 * hstepA, tstepB = 2 * hstepB;
    const unsigned ldsw = (unsigned)wid * 1024u;
    const int aoff = lds_byte(wr * 64 + fr, fq * 8), boff = lds_byte(wc * 32 + fr, fq * 8);
#define PG8_SA(b, h) (((b) * 2 + (h)) * HTB)
#define PG8_SB(b, h) ((4 + (b) * 2 + (h)) * HTB)
#define PG8_STAGE(bufoff, gbase, voff) do { _Pragma("unroll") for (int _i = 0; _i < 2; ++_i) \
        __builtin_amdgcn_global_load_lds((const unsigned*)((const char*)(gbase) + (voff)[_i]), (PG8_LAS unsigned*)(lds + (bufoff) + ldsw + _i * 8192), 16, 0, 0); } while (0)
#define PG8_LDA(dst, b, h) do { _Pragma("unroll") for (int m = 0; m < 4; ++m) _Pragma("unroll") for (int k = 0; k < 2; ++k) dst[m][k] = *(const PG8_LAS bf16x8*)(lds + PG8_SA(b, h) + aoff + m * 2048 + k * 1024); } while (0)
#define PG8_LDB(dst, b, h) do { _Pragma("unroll") for (int n = 0; n < 2; ++n) _Pragma("unroll") for (int k = 0; k < 2; ++k) dst[n][k] = *(const PG8_LAS bf16x8*)(lds + PG8_SB(b, h) + boff + n * 2048 + k * 1024); } while (0)
#define PG8_MMA(ai, bj, At, Bt) do { __builtin_amdgcn_s_setprio(1); _Pragma("unroll") for (int m = 0; m < 4; ++m) _Pragma("unroll") for (int n = 0; n < 2; ++n) _Pragma("unroll") for (int k = 0; k < 2; ++k) \
        acc[ai][bj][m][n] = __builtin_amdgcn_mfma_f32_16x16x32_bf16(Bt[n][k], At[m][k], acc[ai][bj][m][n], 0, 0, 0); __builtin_amdgcn_s_setprio(0); } while (0)
#define PG8_WAIT_V(n) asm volatile("s_waitcnt vmcnt(" #n ")" ::: "memory")
#define PG8_WAIT_L(n) asm volatile("s_waitcnt lgkmcnt(" #n ")" ::: "memory")
#define PG8_BAR __builtin_amdgcn_s_barrier()
#define PG8_SCHED __builtin_amdgcn_sched_barrier(0)
    Unit cur, nxt; int ui = 0;
    if (!S.next(0, cur)) return;
    f32x4 acc[2][2][4][2];
#pragma unroll
    for (int a = 0; a < 2; ++a)
#pragma unroll
        for (int b = 0; b < 2; ++b)
#pragma unroll
            for (int m = 0; m < 4; ++m)
#pragma unroll
                for (int n = 0; n < 2; ++n) acc[a][b][m][n] = (f32x4){0.f, 0.f, 0.f, 0.f};
    bf16x8 At[4][2], B0[2][2], B1[2][2];
    const char* cA = (const char*)g.A + (size_t)cur.pm * tstepA; const char* cB = (const char*)g.Bt + (size_t)cur.pn * tstepB;
    S.a_ready(cur);
    if constexpr (SP2) {
        PG8_STAGE(PG8_SB(0, 0), cB, voffB); PG8_STAGE(PG8_SB(0, 1), cB + hstepB, voffB); PG8_STAGE(PG8_SA(0, 0), cA, voffA); PG8_STAGE(PG8_SA(0, 1), cA + hstepA, voffA);
        if (wr == 1) PG8_BAR;
        PG8_WAIT_V(2); PG8_BAR;
        PG8_STAGE(PG8_SB(1, 0), cB + kstep, voffB); PG8_STAGE(PG8_SA(1, 0), cA + kstep, voffA); PG8_STAGE(PG8_SB(1, 1), cB + hstepB + kstep, voffB);
        PG8_WAIT_V(6); PG8_BAR;
    } else {
        PG8_STAGE(PG8_SB(0, 0), cB, voffB); PG8_STAGE(PG8_SA(0, 0), cA, voffA); PG8_STAGE(PG8_SB(0, 1), cB + hstepB, voffB); PG8_STAGE(PG8_SA(0, 1), cA + hstepA, voffA);
        if (wr == 1) PG8_BAR;
        PG8_WAIT_V(4); PG8_BAR;
        PG8_STAGE(PG8_SB(1, 0), cB + kstep, voffB); PG8_STAGE(PG8_SA(1, 0), cA + kstep, voffA); PG8_STAGE(PG8_SB(1, 1), cB + hstepB + kstep, voffB);
        PG8_WAIT_V(6); PG8_BAR;
    }
    for (;;) {
        const bool has_next = S.next(ui + 1, nxt);
        const char* nA = has_next ? (const char*)g.A + (size_t)nxt.pm * tstepA : cA; const char* nB = has_next ? (const char*)g.Bt + (size_t)nxt.pn * tstepB : cB;
        for (int t = 0; t < nt; t += 2) {
            const bool last = (t == nt - 2);
            const char* a1 = cA + (size_t)(t + 1) * kstep;
            const char* a2 = last ? nA : cA + (size_t)(t + 2) * kstep; const char* b2 = last ? nB : cB + (size_t)(t + 2) * kstep;
            const char* a3 = a2 + kstep; const char* b3 = b2 + kstep;
            if (last && has_next) S.a_ready(nxt);
            if constexpr (SP2) {
            PG8_LDB(B0, 0, 0); PG8_LDB(B1, 0, 1); PG8_SCHED; PG8_LDA(At, 0, 0); PG8_STAGE(PG8_SA(1, 1), a1 + hstepA, voffA);
            PG8_WAIT_V(8); PG8_WAIT_L(0); PG8_BAR; PG8_MMA(0, 0, At, B0); PG8_MMA(0, 1, At, B1); PG8_BAR; PG8_SCHED;
            PG8_LDA(At, 0, 1); PG8_STAGE(PG8_SB(0, 0), b2, voffB); PG8_STAGE(PG8_SB(0, 1), b2 + hstepB, voffB); PG8_STAGE(PG8_SA(0, 0), a2, voffA);
            PG8_WAIT_V(8); PG8_WAIT_L(0); PG8_BAR; PG8_MMA(1, 0, At, B0); PG8_MMA(1, 1, At, B1); PG8_BAR; PG8_SCHED;
            PG8_LDB(B0, 1, 0); PG8_LDB(B1, 1, 1); PG8_SCHED; PG8_LDA(At, 1, 0); PG8_STAGE(PG8_SA(0, 1), a2 + hstepA, voffA);
            PG8_WAIT_V(8); PG8_WAIT_L(0); PG8_BAR; PG8_MMA(0, 0, At, B0); PG8_MMA(0, 1, At, B1); PG8_BAR; PG8_SCHED;
            PG8_LDA(At, 1, 1); PG8_STAGE(PG8_SB(1, 0), b3, voffB); PG8_STAGE(PG8_SB(1, 1), b3 + hstepB, voffB); PG8_STAGE(PG8_SA(1, 0), a3, voffA);
            PG8_WAIT_V(8); PG8_WAIT_L(0); PG8_BAR; PG8_MMA(1, 0, At, B0); PG8_MMA(1, 1, At, B1); PG8_BAR; PG8_SCHED;
            } else {
            PG8_LDB(B0, 0, 0); PG8_SCHED; PG8_LDA(At, 0, 0); PG8_STAGE(PG8_SA(1, 1), a1 + hstepA, voffA);
            PG8_WAIT_L(8); PG8_BAR; PG8_WAIT_L(0); PG8_MMA(0, 0, At, B0); PG8_BAR; PG8_SCHED;
            PG8_LDB(B1, 0, 1); PG8_STAGE(PG8_SB(0, 0), b2, voffB);
            PG8_BAR; PG8_WAIT_L(0); PG8_MMA(0, 1, At, B1); PG8_BAR;
            PG8_LDA(At, 0, 1); PG8_STAGE(PG8_SA(0, 0), a2, voffA);
            PG8_BAR; PG8_WAIT_L(0); PG8_MMA(1, 0, At, B0); PG8_BAR; PG8_SCHED;
            PG8_STAGE(PG8_SB(0, 1), b2 + hstepB, voffB);
            PG8_WAIT_V(6); PG8_BAR; PG8_MMA(1, 1, At, B1); PG8_BAR;
            PG8_LDB(B0, 1, 0); PG8_SCHED; PG8_LDA(At, 1, 0); PG8_STAGE(PG8_SA(0, 1), a2 + hstepA, voffA);
            PG8_WAIT_L(8); PG8_BAR; PG8_WAIT_L(0); PG8_MMA(0, 0, At, B0); PG8_BAR; PG8_SCHED;
            PG8_LDB(B1, 1, 1); PG8_STAGE(PG8_SB(1, 0), b3, voffB);
            PG8_BAR; PG8_WAIT_L(0); PG8_MMA(0, 1, At, B1); PG8_BAR;
            PG8_LDA(At, 1, 1); PG8_STAGE(PG8_SA(1, 0), a3, voffA);
            PG8_BAR; PG8_WAIT_L(0); PG8_MMA(1, 0, At, B0); PG8_BAR; PG8_SCHED;
            PG8_STAGE(PG8_SB(1, 1), b3 + hstepB, voffB);
            PG8_WAIT_V(6); PG8_BAR; PG8_MMA(1, 1, At, B1); PG8_BAR;
            }
        }
        if constexpr (ALIGN_EPI) { if (wr == 0) PG8_BAR; }
        if constexpr (!Epi::AFTER_DRAIN) { E(acc, cur, wr, wc, fr, fq); S.done(cur); }
        if (!has_next) break;
#pragma unroll
        for (int a = 0; a < 2; ++a)
#pragma unroll
            for (int b = 0; b < 2; ++b)
#pragma unroll
                for (int m = 0; m < 4; ++m)
#pragma unroll
                    for (int n = 0; n < 2; ++n) acc[a][b][m][n] = (f32x4){0.f, 0.f, 0.f, 0.f};
        cur = nxt; cA = nA; cB = nB; ++ui;
        if constexpr (ALIGN_EPI) { if (wr == 1) PG8_BAR; }
    }
    PG8_WAIT_V(0);
    if constexpr (!ALIGN_EPI) { if (wr == 0) PG8_BAR; }
    PG8_BAR;
    if constexpr (Epi::AFTER_DRAIN) { E.fused(acc, cur, wr, wc, fr, fq, lds, wid, lane); S.done(cur); }
#undef PG8_SA
#undef PG8_SB
#undef PG8_STAGE
#undef PG8_LDA
#undef PG8_LDB
#undef PG8_MMA
#undef PG8_WAIT_V
#undef PG8_WAIT_L
#undef PG8_BAR
#undef PG8_SCHED
}
}

namespace pg8 {
template <int ACT> struct EpiScaleBf16 {
    static constexpr bool PERM = true, AFTER_DRAIN = false;
    bf16_t* O; int ldc; const float* ssp; bf16_t* halo; float* small;
    __device__ __forceinline__ void operator()(const f32x4 (&acc)[2][2][4][2], const Unit& u, int wr, int wc, int fr, int fq) const {
        const int row0 = u.pm * BM + wr * 64 + fr, col0 = u.pn * BM + wc * 32 + 8 * fq;
        float rsv[8];
#pragma unroll
        for (int k = 0; k < 8; ++k) { const f32x4 p = *(const f32x4*)(ssp + (size_t)(row0 + (k >> 2) * HALF + (k & 3) * 16) * 16 + 4 * fq); rsv[k] = (p[0] + p[1]) + (p[2] + p[3]); }
#pragma unroll
        for (int k = 0; k < 8; ++k) { float t = rsv[k]; t += __shfl_xor(t, 16); t += __shfl_xor(t, 32); rsv[k] = rsqrt_f(t * (1.f / DM) + NORM_EPS); }
#pragma unroll
        for (int ai = 0; ai < 2; ++ai)
#pragma unroll
            for (int m = 0; m < 4; ++m) { const int row = row0 + ai * HALF + m * 16; const float rs = rsv[ai * 4 + m]; bf16_t* rowp = O + (size_t)row * ldc + col0;
#pragma unroll
                for (int bj = 0; bj < 2; ++bj) { f32x4 v0 = acc[ai][bj][m][0] * rs, v1 = acc[ai][bj][m][1] * rs;
                    if (ACT == 0 && u.pn == NP / BM) {
                        if (bj == 0 && wc == 0 && fq < 2) { *(f32x4*)(small + (size_t)row * 16 + 8 * fq) = v0; *(f32x4*)(small + (size_t)row * 16 + 8 * fq + 4) = v1; }
                        continue; }
                    if (ACT == 1) {
#pragma unroll
                        for (int i = 0; i < 4; ++i) { const float a = fmaxf(v0[i], 0.f), b = fmaxf(v1[i], 0.f); v0[i] = a * a; v1[i] = b * b; } }
                    u32x4 w; w.x = cvt_pk_bf16(v0[0], v0[1]); w.y = cvt_pk_bf16(v0[2], v0[3]); w.z = cvt_pk_bf16(v1[0], v1[1]); w.w = cvt_pk_bf16(v1[2], v1[3]);
                    *(u32x4*)(rowp + bj * HALF) = w;
                    if (ACT == 0 && m == 3) { if (halo && fr >= 13 && (u.pn == 8 || u.pn == 9 || u.pn == 18 || u.pn == 19)) { const int col = col0 + bj * HALF;
                        const int ch = (u.pn < 10) ? (512 + col - C_SB) : (col - C_SX);
                        *(u32x4*)(halo + ((size_t)(row >> 6) * 3 + (fr - 13)) * 1024 + ch) = w; } } } }
    }
};
struct EpiRes {
    static constexpr bool PERM = false, AFTER_DRAIN = false;
    const float* base; float* outx; bf16_t* xb; float* ss_out;
    __device__ __forceinline__ void operator()(const f32x4 (&acc)[2][2][4][2], const Unit& u, int wr, int wc, int fr, int fq) const {
        typedef unsigned u32x2v __attribute__((ext_vector_type(2)));
        const int row0 = u.pm * BM + wr * 64 + fr, col0 = u.pn * BM + wc * 32 + 4 * fq;
#pragma unroll
        for (int ai = 0; ai < 2; ++ai)
#pragma unroll
            for (int m = 0; m < 4; ++m) { const int row = row0 + ai * HALF + m * 16; const size_t off = (size_t)row * DM + col0; float sq = 0.f;
#pragma unroll
                for (int bj = 0; bj < 2; ++bj)
#pragma unroll
                    for (int n = 0; n < 2; ++n) { const size_t o = off + bj * HALF + n * 16; const f32x4 xn = *(const f32x4*)(base + o) + acc[ai][bj][m][n];
                        *(f32x4*)(outx + o) = xn; u32x2v w; w.x = cvt_pk_bf16(xn[0], xn[1]); w.y = cvt_pk_bf16(xn[2], xn[3]); *(u32x2v*)(xb + o) = w;
                        sq += (xn[0] * xn[0] + xn[1] * xn[1]) + (xn[2] * xn[2] + xn[3] * xn[3]); }
                sq += __shfl_xor(sq, 16); sq += __shfl_xor(sq, 32);
                if (fq == 0) ss_out[(size_t)row * 16 + u.pn * 4 + wc] = sq; }
    }
};
}

#define GAS __attribute__((address_space(1)))
#define LAS __attribute__((address_space(3)))
constexpr int NWAVES = 8;
constexpr int RING_OFF = 0, RING_BYTES = 131072;
constexpr int LDSCTL_OFF = 161792, MISC_OFF = LDSCTL_OFF + 320;
constexpr int LDS_BYTES = 163840;
constexpr int CW_BAR = 4096;
constexpr size_t CTL_ZERO_BYTES = 64 * 1024;
typedef unsigned v4u __attribute__((ext_vector_type(4)));
#define LDS_WAIT() asm volatile("s_waitcnt lgkmcnt(0)" ::: "memory")
#define XB_TMO      128
#define XB_XCNT(j)  (256  + 64 * (j))
#define XB_XSUB(j)  (1280 + 64 * (j))
#define XB_XGEN(j)  (2304 + 64 * (j))
#define XB_TOP      3328
#define XB_TOPGEN   3392
#define XCD_BAR_WORDS 3456
#define XB_SPIN_CAP (1u << 18)

__device__ __forceinline__ unsigned xb_ld(unsigned* p)              { return __hip_atomic_load(p, __ATOMIC_RELAXED, __HIP_MEMORY_SCOPE_AGENT); }
__device__ __forceinline__ unsigned xb_add(unsigned* p, unsigned v) { return __hip_atomic_fetch_add(p, v, __ATOMIC_RELAXED, __HIP_MEMORY_SCOPE_AGENT); }
__device__ __forceinline__ unsigned xb_xcc_id() { return (unsigned)__builtin_amdgcn_s_getreg((3 << 11) | 20) & 0xFu; }
#define XB_SPIN(cond, bar) do { unsigned _sp = 0; while (cond) { __builtin_amdgcn_s_sleep(1); \
    if ((++_sp & 255u) == 0u) { if (xb_ld(&(bar)[XB_TMO])) break; if (_sp > XB_SPIN_CAP) { atomicAdd(&(bar)[XB_TMO], 1u); break; } } } } while (0)

struct XcdBarrier {
    unsigned* bar; unsigned x;
    volatile LAS unsigned* st;
};

__device__ __forceinline__ XcdBarrier xcd_barrier_post(unsigned* bar, volatile LAS unsigned* st) {
    XcdBarrier b; b.bar = bar; b.x = xb_xcc_id(); b.st = st;
    if (threadIdx.x == 0) (void)xb_add(&bar[XB_XCNT(b.x)], 1u);
    return b;
}
__device__ __forceinline__ void xcd_barrier_complete(unsigned* bar, unsigned x, unsigned& nloc, unsigned& nx) {
    const unsigned G = gridDim.x * gridDim.y * gridDim.z;
    unsigned sum, cnt, mine, sp = 0u;
    for (;;) {
        sum = 0u; cnt = 0u; mine = 0u;
#pragma unroll
        for (unsigned j = 0; j < 16; ++j) { const unsigned c = xb_ld(&bar[XB_XCNT(j)]); sum += c; cnt += (c > 0u) ? 1u : 0u; mine = (j == x) ? c : mine; }
        if (sum == G) break;
        __builtin_amdgcn_s_sleep(1);
        if ((++sp & 255u) == 0u) { if (xb_ld(&bar[XB_TMO])) break; if (sp > XB_SPIN_CAP) { atomicAdd(&bar[XB_TMO], 1u); break; } }
    }
    nloc = mine > 0u ? mine : 1u; nx = cnt > 0u ? cnt : 1u;
}

__device__ __forceinline__ void xcd_barrier(const XcdBarrier& b) {
    asm volatile("s_waitcnt vmcnt(0)" ::: "memory");
    __syncthreads();
    if (threadIdx.x == 0) {
        unsigned* bar = b.bar;
        __builtin_amdgcn_s_waitcnt(0);
        unsigned nloc = b.st[0], nx = b.st[1];
        if (nloc == 0u) { xcd_barrier_complete(bar, b.x, nloc, nx); b.st[0] = nloc; b.st[1] = nx; }
        const unsigned old = xb_add(&bar[XB_XSUB(b.x)], 1u);
        const unsigned gen = old / nloc;
        if (old + 1u == (gen + 1u) * nloc) {
            __builtin_amdgcn_fence(__ATOMIC_RELEASE, "agent");
            asm volatile("s_waitcnt vmcnt(0)" ::: "memory");
            const unsigned og = xb_add(&bar[XB_TOP], 1u);
            const unsigned tg = og / nx;
            if (og + 1u == (tg + 1u) * nx) xb_add(&bar[XB_TOPGEN], 1u);
            else XB_SPIN(xb_ld(&bar[XB_TOPGEN]) == tg, bar);
            __builtin_amdgcn_fence(__ATOMIC_ACQUIRE, "agent");
            xb_add(&bar[XB_XGEN(b.x)], 1u);
            asm volatile("s_waitcnt vmcnt(0)" ::: "memory");
        } else {
            XB_SPIN(xb_ld(&bar[XB_XGEN(b.x)]) == gen, bar);
            __builtin_amdgcn_fence(__ATOMIC_ACQUIRE, "agent");
            asm volatile("s_waitcnt vmcnt(0)" ::: "memory");
        }
    }
    __syncthreads();
}

template <bool MAPIN> __device__ __forceinline__ void transpose_item(const float* W, int K, int Nsrc, int Ndst, int Nvalid, const float* kscale, bf16_t* WT, LAS float* scr, int item, int lane) {
    const int nblk = (Ndst + 31) / 32, kb = item / nblk, nb = item % nblk, k0 = 64 * kb, n0 = 32 * nb;
    const int nn = n0 + (lane & 31); const bool ok = nn < Nvalid; const int sc = MAPIN ? c_new2orig(ok ? nn : 0) : nn;
#pragma unroll 8
    for (int i = 0; i < 32; ++i) { const int kk = 2 * i + (lane >> 5); float v = ok ? __builtin_nontemporal_load(&W[(size_t)(k0 + kk) * Nsrc + sc]) : 0.f; if (kscale) v *= kscale[k0 + kk]; scr[kk * 33 + (lane & 31)] = v; }
    LDS_WAIT(); asm volatile("" ::: "memory");
    const int c = lane & 7;
#pragma unroll
    for (int j = 0; j < 4; ++j) { const int n = (lane >> 3) + 8 * j; const LAS float* s = scr + (8 * c) * 33 + n;
        v4u o; o.x = pk2(s[0 * 33], s[1 * 33]); o.y = pk2(s[2 * 33], s[3 * 33]); o.z = pk2(s[4 * 33], s[5 * 33]); o.w = pk2(s[6 * 33], s[7 * 33]);
        if (n0 + n < Ndst) *(v4u*)(WT + (size_t)(n0 + n) * K + k0 + 8 * c) = o; }
    LDS_WAIT(); asm volatile("" ::: "memory");
}
__device__ __forceinline__ void convert_layer_weights(const Params& P, int layer, LAS float* scr, int gw, int NGW, int lane, int which = 0) {
    unsigned char* wset = P.ws + WS_W + (size_t)(layer & 1) * WSET;
    constexpr int I_IN = (DM / 64) * (NPX / 32), I_OUT = (MIXW / 64) * (DM / 32), I_UP = (DM / 64) * (DFF / 32), I_DN = (DFF / 64) * (DM / 32);
    const int lo = (which == 2) ? I_IN : 0, hi = (which == 1) ? I_IN : I_IN + I_OUT + I_UP + I_DN;
    for (int it = lo + gw; it < hi; it += NGW) {
        int r = it;
        if (r < I_IN) { transpose_item<true>(P.w_in + (size_t)layer * DM * DIN, DM, DIN, NPX, DIN, P.mix_norm_w + layer * DM, (bf16_t*)(wset + W_IN), scr, r, lane); continue; } r -= I_IN;
        if (r < I_OUT) { transpose_item<false>(P.w_out + (size_t)layer * MIXW * DM, MIXW, DM, DM, DM, nullptr, (bf16_t*)(wset + W_OUT), scr, r, lane); continue; } r -= I_OUT;
        if (r < I_UP) { transpose_item<false>(P.w_up + (size_t)layer * DM * DFF, DM, DFF, DFF, DFF, P.mlp_norm_w + layer * DM, (bf16_t*)(wset + W_UP), scr, r, lane); continue; } r -= I_UP;
        transpose_item<false>(P.w_down + (size_t)layer * DFF * DM, DFF, DM, DM, DM, nullptr, (bf16_t*)(wset + W_DOWN), scr, r, lane);
    }
}
typedef short bf16x8 __attribute__((ext_vector_type(8)));
typedef float f32x16 __attribute__((ext_vector_type(16)));
typedef unsigned short u16x8 __attribute__((ext_vector_type(8)));
typedef unsigned v2u __attribute__((ext_vector_type(2)));
typedef float f32x4_t __attribute__((ext_vector_type(4)));
__device__ __forceinline__ v4u mk4(unsigned a, unsigned b, unsigned c, unsigned d) { v4u r; r.x = a; r.y = b; r.z = c; r.w = d; return r; }
#define MFMA32(a, b, c) __builtin_amdgcn_mfma_f32_32x32x16_bf16((a), (b), (c), 0, 0, 0)
__device__ __forceinline__ int crow(int i, int h) { return (i & 3) + 8 * (i >> 2) + 4 * h; }
template <int KS> __device__ __forceinline__ void mma_nt(f32x16& acc, const LAS unsigned char* A, int lda, const LAS unsigned char* Bt, int ldb, int r, int h) {
#pragma unroll
    for (int ks = 0; ks < KS; ++ks) {
        const bf16x8 a = *(const LAS bf16x8*)(A + r * lda + ks * 32 + h * 16);
        const bf16x8 b = *(const LAS bf16x8*)(Bt + r * ldb + ks * 32 + h * 16);
        acc = MFMA32(a, b, acc);
    }
}
__device__ __forceinline__ void store_acc_T(const f32x16& v, LAS unsigned char* dst, int ldt, int r, int h) {
#pragma unroll
    for (int g = 0; g < 4; ++g) { v2u w; w.x = pk2(v[4 * g], v[4 * g + 1]); w.y = pk2(v[4 * g + 2], v[4 * g + 3]); *(LAS v2u*)(dst + r * ldt + (8 * g + 4 * h) * 2) = w; }
}
__device__ __forceinline__ float bfsel(const v4u& v, int c) { const unsigned u = v[c >> 1]; return __uint_as_float((c & 1) ? (u & 0xffff0000u) : (u << 16)); }
__device__ __forceinline__ f32x16 zero16() { f32x16 z;
#pragma unroll
    for (int i = 0; i < 16; ++i) z[i] = 0.f; return z; }

__device__ __forceinline__ bf16x8 pack_acc(const f32x16& x, int s) {
    v4u p; p.x = pk2(x[8 * s], x[8 * s + 1]); p.y = pk2(x[8 * s + 2], x[8 * s + 3]); p.z = pk2(x[8 * s + 4], x[8 * s + 5]); p.w = pk2(x[8 * s + 6], x[8 * s + 7]);
    return __builtin_bit_cast(bf16x8, p);
}
__device__ __forceinline__ void store_rows_bf16(bf16_t* base_row4h, const int pitch, const f32x16& y0, const f32x16& y1) {
    bf16_t* p = base_row4h;
#pragma unroll
    for (int cb = 0; cb < 2; ++cb)
#pragma unroll
        for (int g = 0; g < 4; ++g) { asm volatile("" : "+v"(p));
#pragma unroll
            for (int q = 0; q < 4; ++q) { p[(size_t)q * pitch] = f2bf(cb == 0 ? y0[4 * g + q] : y1[4 * g + q]); }
            p += (size_t)8 * pitch; }
}
typedef short s16x4 __attribute__((ext_vector_type(4)));
__device__ __forceinline__ bf16x8 tr_frag(const LAS unsigned char* p, const int stride) {
    const s16x4 a = __builtin_amdgcn_ds_read_tr16_b64_v4i16((LAS s16x4*)p), b = __builtin_amdgcn_ds_read_tr16_b64_v4i16((LAS s16x4*)(p + 4 * stride));
    return __builtin_shufflevector(a, b, 0, 1, 2, 3, 4, 5, 6, 7);
}
__device__ __forceinline__ void store_cols_bf16(bf16_t* base, const size_t pitch, const f32x16& y0, const f32x16& y1) {
    typedef __attribute__((address_space(1))) v2u* gp_t;
#pragma unroll
    for (int lb = 0; lb < 2; ++lb)
#pragma unroll
        for (int g = 0; g < 4; ++g) { v2u o; o.x = lb == 0 ? pk2(y0[4 * g], y0[4 * g + 1]) : pk2(y1[4 * g], y1[4 * g + 1]); o.y = lb == 0 ? pk2(y0[4 * g + 2], y0[4 * g + 3]) : pk2(y1[4 * g + 2], y1[4 * g + 3]);
            *(gp_t)(base + (size_t)lb * 32 * pitch + 8 * g) = o; }
}
#define WG_BAR() do { asm volatile("s_waitcnt lgkmcnt(0)" ::: "memory"); __builtin_amdgcn_s_barrier(); asm volatile("" ::: "memory"); } while (0)
__device__ __forceinline__ void ret_prep_rot(const Params& P, int gt, int ng) {
    bf16_t* proj = (bf16_t*)(P.ws + WS_PROJ); const float* cs = (const float*)(P.ws + WS_COS); const float* sn = (const float*)(P.ws + WS_SIN);
    for (int idx = gt; idx < T * 32; idx += ng) { const int row = idx >> 5, hd = (idx >> 3) & 3, i0 = (idx & 7) * 8;
        bf16_t* pr = proj + (size_t)row * NP + hd * 128 + i0;
        const v4u q1 = *(const v4u*)(pr + C_RQ), q2 = *(const v4u*)(pr + C_RQ + 64), k1 = *(const v4u*)(pr + C_RK), k2 = *(const v4u*)(pr + C_RK + 64);
        const f32x4_t c0 = *(const f32x4_t*)(cs + (size_t)row * 64 + i0), c1 = *(const f32x4_t*)(cs + (size_t)row * 64 + i0 + 4), s0 = *(const f32x4_t*)(sn + (size_t)row * 64 + i0), s1 = *(const f32x4_t*)(sn + (size_t)row * 64 + i0 + 4);
        const float cc[8] = {c0[0], c0[1], c0[2], c0[3], c1[0], c1[1], c1[2], c1[3]}, ss_[8] = {s0[0], s0[1], s0[2], s0[3], s1[0], s1[1], s1[2], s1[3]};
        const float lg = log2f(1.f - exp2f(-5.f - (float)hd)), zeta = __builtin_amdgcn_exp2f((float)(63 - (row & 63)) * lg);
        float qa[8], qb[8], ka[8], kb[8];
#pragma unroll
        for (int j = 0; j < 8; ++j) { const float a1 = bfsel(q1, j), a2 = bfsel(q2, j), b1 = bfsel(k1, j), b2 = bfsel(k2, j);
            qa[j] = (a1 * cc[j] - a2 * ss_[j]) * 0.08838834764831845f; qb[j] = (a2 * cc[j] + a1 * ss_[j]) * 0.08838834764831845f; ka[j] = (b1 * cc[j] - b2 * ss_[j]) * zeta; kb[j] = (b2 * cc[j] + b1 * ss_[j]) * zeta; }
        *(v4u*)(pr + C_RQ) = mk4(pk2(qa[0], qa[1]), pk2(qa[2], qa[3]), pk2(qa[4], qa[5]), pk2(qa[6], qa[7]));
        *(v4u*)(pr + C_RQ + 64) = mk4(pk2(qb[0], qb[1]), pk2(qb[2], qb[3]), pk2(qb[4], qb[5]), pk2(qb[6], qb[7]));
        *(v4u*)(pr + C_RK) = mk4(pk2(ka[0], ka[1]), pk2(ka[2], ka[3]), pk2(ka[4], ka[5]), pk2(ka[6], ka[7]));
        *(v4u*)(pr + C_RK + 64) = mk4(pk2(kb[0], kb[1]), pk2(kb[2], kb[3]), pk2(kb[4], kb[5]), pk2(kb[6], kb[7])); }
}
__device__ __forceinline__ void ret_prep_vt(const Params& P, int task, int tid) {
    bf16_t* proj = (bf16_t*)(P.ws + WS_PROJ);
    const int bh = task >> 6, n = task & 63, b = bh >> 2, hd = bh & 3, e = tid & 127, tg = tid >> 7;
    bf16_t* base = proj + ((size_t)b * SEQ + n * 64) * NP + C_RV + hd * 128;
    unsigned short v[16];
#pragma unroll
    for (int j = 0; j < 16; ++j) v[j] = base[(size_t)(16 * tg + j) * NP + e];
    const v4u o0 = mk4(v[0] | ((unsigned)v[1] << 16), v[2] | ((unsigned)v[3] << 16), v[4] | ((unsigned)v[5] << 16), v[6] | ((unsigned)v[7] << 16));
    const v4u o1 = mk4(v[8] | ((unsigned)v[9] << 16), v[10] | ((unsigned)v[11] << 16), v[12] | ((unsigned)v[13] << 16), v[14] | ((unsigned)v[15] << 16));
    __syncthreads();
    bf16_t* dst = base + (size_t)(e >> 1) * NP + (e & 1) * 64 + 16 * tg;
    *(v4u*)dst = o0; *(v4u*)(dst + 8) = o1;
}
constexpr int NSR = 2, NSS = 2, NSG = 1, RSPLIT = 36, SSPLIT = 36;
constexpr int WG_RET = 16 * NSR, WG_GDN = 16 * NSG, WG_SSD = 32 * NSS, WG_SEQ = WG_RET + WG_GDN + WG_SSD;
__device__ __forceinline__ int rseg_lo(int s) { return NSR == 1 ? (s == 0 ? 0 : 64) : NSR == 2 ? (s == 0 ? 0 : (s == 1 ? RSPLIT : 64)) : (s == 0 ? 0 : (s == 1 ? 32 : (s == 2 ? 52 : 64))); }
__device__ __forceinline__ int gseg_lo(int s) { return NSG == 1 ? (s == 0 ? 0 : 64) : (s == 0 ? 0 : (s == 1 ? 45 : 64)); }
__device__ __forceinline__ int sseg_lo(int s) { return NSS == 1 ? (s == 0 ? 0 : 64) : NSS == 2 ? (s == 0 ? 0 : (s == 1 ? SSPLIT : 64)) : (s == 0 ? 0 : (s == 1 ? 32 : (s == 2 ? 52 : 64))); }
constexpr int RS_Q = 0, RS_P = 17408, RS_V = 26624, RS_K = 45056, RS_BUF = 62464, RS_END = 2 * RS_BUF;
__device__ __forceinline__ void ret_seq(const Params& P, int layer, int prob, LAS unsigned char* L, int tid_in, bool dry = false) {
    bf16_t* proj = (bf16_t*)(P.ws + WS_PROJ);
    const int seg = prob % NSR, b = (prob / NSR) >> 2, hd = (prob / NSR) & 3, w = __builtin_amdgcn_readfirstlane(tid_in >> 6);
    const int n_full = rseg_lo(seg), n_end = rseg_lo(seg + 1);
    const float lg = log2f(1.f - exp2f(-5.f - (float)hd));
    const size_t rowb = (size_t)b * SEQ;
    if (w >= 4) {
        const int ht = tid_in - 256, last = n_end - 1;
        v4u PFA[12], PFB[12];
#define RET_LD(PF, chunk) do { const int c_ = min((chunk), last), cq_ = max(c_, n_full); const bf16_t* rk_ = proj + (rowb + (size_t)c_ * 64) * NP + hd * 128; const bf16_t* rq_ = proj + (rowb + (size_t)cq_ * 64) * NP + hd * 128; \
            _Pragma("unroll") for (int q = 0; q < 12; ++q) { const int vv = ht + 256 * (q & 3); const size_t o_ = (size_t)(vv >> 4) * NP + (vv & 15) * 8; \
                PF[q] = *(const v4u*)((q < 4) ? rq_ + C_RQ + o_ : ((q < 8) ? rk_ + C_RK + o_ : rk_ + C_RV + o_)); } } while (0)
#define RET_HBODY(n_, PF) do { const int n = (n_); int tid = tid_in; asm volatile("" : "+v"(tid)); const int lane = tid & 63, r = lane & 31, h = lane >> 5; \
            LAS unsigned char* Tn = L + ((n + 1) & 1) * RS_BUF; const bool fulln = (n + 1 >= n_full);     \
            _Pragma("unroll") for (int q = 0; q < 12; ++q) { const int vv = (tid - 256) + 256 * (q & 3), row = vv >> 4, c0 = (vv & 15) * 8; \
                *(LAS v4u*)((q < 8) ? Tn + ((q < 4) ? RS_Q : RS_K) + row * 272 + c0 * 2 : Tn + RS_V + (2 * row + (c0 >> 6)) * 144 + (c0 & 63) * 2) = PF[q]; }     \
            if (n + 1 >= n_full) WG_BAR();     \
            if (n + 1 < n_end && fulln && w < 7) {     \
                const int t = w - 4, ib = (t + 1) >> 1, jb = t >> 1; f32x16 sacc = zero16(); \
                mma_nt<8>(sacc, Tn + RS_Q + ib * 32 * 272, 272, Tn + RS_K + jb * 32 * 272, 272, r, h); \
                const int jj = jb * 32 + r; \
                _Pragma("unroll") for (int i = 0; i < 16; ++i) { const int ii = ib * 32 + crow(i, h); \
                    *(LAS bf16_t*)(Tn + RS_P + ii * 144 + jj * 2) = f2bf((ii >= jj) ? sacc[i] * __builtin_amdgcn_exp2f((float)(ii - 63) * lg) : 0.f); } } \
            RET_LD(PF, n + 3);     \
            WG_BAR();     } while (0)
        RET_LD(PFA, 0); RET_LD(PFB, 1);
#pragma unroll 1
        for (int m = -1; m < n_end; m += 2) { RET_HBODY(m, PFA); if (m + 1 >= n_end) break; RET_HBODY(m + 1, PFB); }
#undef RET_LD
#undef RET_HBODY
        return;
    }
    const int vs = w; const float cdec = exp2f(64.f * lg);
    f32x16 S[4];
#pragma unroll
    for (int k = 0; k < 4; ++k) S[k] = zero16();
#pragma unroll 1
    for (int n = -1; n < n_end; ++n) {
        int tid = tid_in; asm volatile("" : "+v"(tid));
        const int lane = tid & 63, r = lane & 31, h = lane >> 5;
        const LAS unsigned char* Tt = L + (n & 1) * RS_BUF; const bool full = (n >= n_full);
#define RET_STATE() do { const LAS unsigned char* kp = Tt + RS_K + (8 * h + ((lane & 15) >> 2)) * 272 + (16 * ((lane >> 4) & 1) + 4 * (lane & 3)) * 2; \
            _Pragma("unroll") for (int kb = 0; kb < 4; ++kb) S[kb] = S[kb] * cdec; \
            _Pragma("unroll") for (int ks = 0; ks < 4; ++ks) { const bf16x8 vb = *(const LAS bf16x8*)(Tt + RS_V + (vs * 32 + r) * 144 + (ks * 16 + 8 * h) * 2); \
                _Pragma("unroll") for (int kb = 0; kb < 4; ++kb) S[kb] = MFMA32(tr_frag(kp + ks * 16 * 272 + kb * 64, 272), vb, S[kb]); } } while (0)
        if (n >= 0 && full) {
            f32x16 y[2];
            v4u qf[16];
#pragma unroll
            for (int i = 0; i < 16; ++i) { const LAS unsigned char* ap = Tt + RS_Q + ((i & 1) * 32 + r) * 272 + ((i >> 1) * 16 + 4 * h) * 2;
                const v2u a0 = *(const LAS v2u*)ap, a1 = *(const LAS v2u*)(ap + 16); qf[i].x = a0.x; qf[i].y = a0.y; qf[i].z = a1.x; qf[i].w = a1.y; }
            __builtin_amdgcn_sched_barrier(0);
#pragma unroll
            for (int kb = 0; kb < 4; ++kb)
#pragma unroll
                for (int s = 0; s < 2; ++s) { const bf16x8 sa = pack_acc(S[kb], s);
#pragma unroll
                    for (int lb = 0; lb < 2; ++lb) y[lb] = (kb == 0 && s == 0) ? MFMA32(sa, __builtin_bit_cast(bf16x8, qf[lb]), zero16()) : MFMA32(sa, __builtin_bit_cast(bf16x8, qf[(kb * 2 + s) * 2 + lb]), y[lb]); }
#pragma unroll
            for (int lb = 0; lb < 2; ++lb) y[lb] = y[lb] * __builtin_amdgcn_exp2f((float)(lb * 32 + r + 1) * lg);
            WG_BAR();
#pragma unroll
            for (int lb = 0; lb < 2; ++lb)
#pragma unroll
                for (int ks = 0; ks < 4; ++ks) { if (ks >= 2 * lb + 2) continue;
                    y[lb] = MFMA32(*(const LAS bf16x8*)(Tt + RS_V + (vs * 32 + r) * 144 + (ks * 16 + 8 * h) * 2), *(const LAS bf16x8*)(Tt + RS_P + (lb * 32 + r) * 144 + (ks * 16 + 8 * h) * 2), y[lb]); }
            RET_STATE();
            if (!dry) store_cols_bf16(proj + (rowb + (size_t)n * 64 + r) * NP + C_RQ + hd * 128 + vs * 32 + 4 * h, NP, y[0], y[1]);
        } else {
            if (n + 1 >= n_full) WG_BAR();
            if (n >= 0) RET_STATE();
        }
#undef RET_STATE
        WG_BAR();
    }
}
__device__ __forceinline__ void ret_norm(const Params& P, int layer, int gt, int ng) {
    bf16_t* proj = (bf16_t*)(P.ws + WS_PROJ);
    for (int it = gt; it < T * 4 * 16; it += ng) { const int item = it >> 4, cg = it & 15, row = item >> 2, hd = item & 3;
        bf16_t* yp = proj + (size_t)row * NP + C_RV + hd * 128 + cg * 8;
        const u16x8 yv = *(const u16x8*)yp; const u16x8 zv = *(const u16x8*)(proj + (size_t)row * NP + C_RG + hd * 128 + cg * 8);
        float v[8], sq = 0.f;
#pragma unroll
        for (int j = 0; j < 8; ++j) { v[j] = bf2f(yv[j]); sq += v[j] * v[j]; }
        sq += __shfl_xor(sq, 1); sq += __shfl_xor(sq, 2); sq += __shfl_xor(sq, 4); sq += __shfl_xor(sq, 8);
        const float rs = rsqrt_f(sq * (1.f / 128.f) + NORM_EPS); const float* nwp = P.ret_norm_w + layer * 512 + hd * 128 + cg * 8;
#pragma unroll
        for (int j = 0; j < 8; ++j) v[j] = v[j] * rs * nwp[j] * silu_f(bf2f(zv[j]));
        *(v4u*)yp = mk4(pk2(v[0], v[1]), pk2(v[2], v[3]), pk2(v[4], v[5]), pk2(v[6], v[7])); }
}

__device__ __forceinline__ void gdn_norm(const Params& P, int layer, int gt, int ng) {
    bf16_t* proj = (bf16_t*)(P.ws + WS_PROJ);
    for (int it = gt; it < T * 4 * 16; it += ng) { const int item = it >> 4, cg = it & 15, row = item >> 2, hd = item & 3;
        bf16_t* yp = proj + (size_t)row * NP + C_GV + hd * 128 + cg * 8;
        const u16x8 yv = *(const u16x8*)yp; const u16x8 zv = *(const u16x8*)(proj + (size_t)row * NP + C_GZ + hd * 128 + cg * 8);
        float v[8], sq = 0.f;
#pragma unroll
        for (int j = 0; j < 8; ++j) { v[j] = bf2f(yv[j]); sq += v[j] * v[j]; }
        sq += __shfl_xor(sq, 1); sq += __shfl_xor(sq, 2); sq += __shfl_xor(sq, 4); sq += __shfl_xor(sq, 8);
        const float rs = rsqrt_f(sq * (1.f / 128.f) + NORM_EPS); const float* nwp = P.gdn_norm_w + layer * 128 + cg * 8;
#pragma unroll
        for (int j = 0; j < 8; ++j) v[j] = v[j] * rs * nwp[j] * silu_f(bf2f(zv[j]));
        *(v4u*)yp = mk4(pk2(v[0], v[1]), pk2(v[2], v[3]), pk2(v[4], v[5]), pk2(v[6], v[7])); }
}
__device__ __forceinline__ void ssd_prep(const Params& P, int layer, int task, int tid) {
    bf16_t* proj = (bf16_t*)(P.ws + WS_PROJ); float* sm = (float*)(P.ws + WS_SMALL); float* acsb = (float*)(P.ws + WS_ACS); const bf16_t* halo = (const bf16_t*)(P.ws + WS_HALO);
    const int b = task >> 7, g = (task >> 6) & 1, n = task & 63, w = __builtin_amdgcn_readfirstlane(tid >> 6), cgp = tid & 63, lane = tid & 63;
    const size_t row0 = (size_t)b * SEQ + n * 64; const int chunk = b * 64 + n;
    const int colb = (cgp < 32) ? (C_SX + g * 256 + 8 * cgp) : ((cgp < 48) ? (C_SB + g * 128 + 8 * (cgp - 32)) : (C_SC + g * 128 + 8 * (cgp - 48)));
    const int chb = (cgp < 32) ? (g * 256 + 8 * cgp) : ((cgp < 48) ? (512 + g * 128 + 8 * (cgp - 32)) : (768 + g * 128 + 8 * (cgp - 48)));
    v4u R[11];
#pragma unroll
    for (int j = 0; j < 11; ++j) { const int tokrel = 8 * w + j - 3;
        if (tokrel >= 0) R[j] = *(const v4u*)(proj + (row0 + tokrel) * NP + colb);
        else if (n > 0) R[j] = *(const v4u*)(halo + ((size_t)(chunk - 1) * 3 + j) * 1024 + chb);
        else R[j] = mk4(0u, 0u, 0u, 0u); }
    const float* cw = P.ssd_conv_w + (size_t)layer * 4 * 1024 + chb; const float* cbp = P.ssd_conv_b + layer * 1024 + chb;
    v4u tokv[8];
#pragma unroll
    for (int j = 0; j < 8; ++j) tokv[j] = mk4(0u, 0u, 0u, 0u);
    v4u chv[8];
#pragma unroll
    for (int c = 0; c < 8; ++c) { const float w0 = cw[c], w1 = cw[1024 + c], w2 = cw[2048 + c], w3 = cw[3072 + c], bs = cbp[c]; float o[8];
#pragma unroll
        for (int j = 0; j < 8; ++j) { const float a = w0 * bfsel(R[j], c) + w1 * bfsel(R[j + 1], c) + w2 * bfsel(R[j + 2], c) + w3 * bfsel(R[j + 3], c) + bs;
            o[j] = a * __builtin_amdgcn_rcpf(1.f + __expf(-a)); }
        chv[c] = mk4(pk2(o[0], o[1]), pk2(o[2], o[3]), pk2(o[4], o[5]), pk2(o[6], o[7]));
#pragma unroll
        for (int j = 0; j < 8; ++j) { const unsigned hv = (chv[c][j >> 1] >> (16 * (j & 1))) & 0xffffu; tokv[j][c >> 1] |= hv << (16 * (c & 1)); } }
    float dtv = 0.f, acv = 0.f;
    if (w < 4) {
        const int hg = 4 * g + w; dtv = softplus_f(sm[(row0 + lane) * 16 + hg] + P.ssd_dt_bias[layer * 8 + hg]); acv = dtv * -__expf(P.ssd_a_log[layer * 8 + hg]);
#pragma unroll
        for (int o = 1; o < 64; o <<= 1) { const float t = __shfl_up(acv, o); if (lane >= o) acv += t; } }
    __syncthreads();
    if (cgp < 32) {
#pragma unroll
        for (int c = 0; c < 8; ++c) { const int p = 8 * cgp + c; *(v4u*)(proj + (row0 + (p & 63)) * NP + C_SX + g * 256 + (p >> 6) * 64 + 8 * w) = chv[c]; } }
    else {
#pragma unroll
        for (int j = 0; j < 8; ++j) *(v4u*)(proj + (row0 + 8 * w + j) * NP + colb) = tokv[j]; }
    if (w < 4) { sm[(row0 + lane) * 16 + 4 * g + w] = dtv; acsb[(row0 + lane) * 8 + 4 * g + w] = acv; }
}
constexpr int SQ_C = 0, SQ_W = 17408, SQ_X = 26624, SQ_B = 35840, SQ_A = 53248, SQ_BUF = 54528, SQ_END = 2 * SQ_BUF;
__device__ __forceinline__ void ssd_seq(const Params& P, int layer, int prob, LAS unsigned char* L, int tid_in, bool dry = false) {
    bf16_t* proj = (bf16_t*)(P.ws + WS_PROJ); const float* sm = (const float*)(P.ws + WS_SMALL); const float* acsb = (const float*)(P.ws + WS_ACS);
    const int seg = prob % NSS, b = (prob / NSS) >> 3, hg = (prob / NSS) & 7, g = hg >> 2, hh = hg & 3, w = __builtin_amdgcn_readfirstlane(tid_in >> 6);
    const int n_full = sseg_lo(seg), n_end = sseg_lo(seg + 1);
    const size_t rowb = (size_t)b * SEQ;
    if (w >= 2) {
        const int ht = tid_in - 128, last = n_end - 1; const float dsk = P.ssd_d[layer * 8 + hg];
        v4u PFA[7], PFB[7]; float paA, pdA, paB, pdB;
#define SSD_LD(PF, pa, pd, chunk) do { const int c_ = min((chunk), last), cq_ = max(c_, n_full); const size_t r0_ = rowb + (size_t)c_ * 64, rq_ = rowb + (size_t)cq_ * 64; \
            pa = acsb[(r0_ + (ht & 63)) * 8 + hg]; pd = sm[(r0_ + (ht & 63)) * 16 + hg]; \
            _Pragma("unroll") for (int q = 0; q < 7; ++q) { const int v = min(ht + 384 * q, 2559), vv = v & 1023; \
                const bf16_t* p_ = (v < 1024) ? proj + (rq_ + (vv >> 4)) * NP + C_SC + g * 128 + (vv & 15) * 8 : ((v < 2048) ? proj + (r0_ + (vv >> 4)) * NP + C_SB + g * 128 + (vv & 15) * 8 \
                                                                                                                          : proj + (r0_ + (vv >> 3)) * NP + C_SX + g * 256 + hh * 64 + (vv & 7) * 8); \
                PF[q] = *(const v4u*)p_; } } while (0)
#define SSD_HBODY(n_, PF, pa, pd) do { const int n = (n_); int tid = tid_in; asm volatile("" : "+v"(tid)); const int lane = tid & 63, r = lane & 31, h = lane >> 5; \
            LAS unsigned char* Tn = L + ((n + 1) & 1) * SQ_BUF;         \
            const bool fulln = (n + 1 >= n_full);                       \
            _Pragma("unroll") for (int q = 0; q < 7; ++q) { const int v = min((tid - 128) + 384 * q, 2559), vv = v & 1023; \
                *(LAS v4u*)((v < 2048) ? Tn + ((v < 1024) ? SQ_C : SQ_B) + (vv >> 4) * 272 + (vv & 15) * 16 : Tn + SQ_X + (vv >> 3) * 144 + (vv & 7) * 16) = PF[q]; } \
            if (w == 7) { const float a_end = __shfl(pa, 63);     \
                *(LAS float*)(Tn + SQ_A + lane * 4) = pa; *(LAS float*)(Tn + SQ_A + 256 + lane * 4) = pd; \
                *(LAS float*)(Tn + SQ_A + 512 + lane * 4) = __expf(pa); *(LAS float*)(Tn + SQ_A + 768 + lane * 4) = pd * __expf(a_end - pa); \
                if (lane == 63) *(LAS float*)(Tn + SQ_A + 1024) = __expf(pa); } \
            if (n + 1 >= n_full) WG_BAR();     \
            if (n + 1 < n_end && fulln && w < 5) {     \
                const int t = w - 2, ib = (t + 1) >> 1, jb = t >> 1; f32x16 sacc = zero16(); \
                mma_nt<8>(sacc, Tn + SQ_C + ib * 32 * 272, 272, Tn + SQ_B + jb * 32 * 272, 272, r, h); \
                const LAS float* acs = (const LAS float*)(Tn + SQ_A); const LAS float* dtv = acs + 64; \
                const int m = jb * 32 + r; const float am = acs[m], dm = dtv[m]; \
                _Pragma("unroll") for (int i = 0; i < 16; ++i) { const int l = ib * 32 + crow(i, h); float v = (m <= l) ? sacc[i] * __expf(acs[l] - am) * dm : 0.f; if (m == l) v += dsk; \
                    *(LAS bf16_t*)(Tn + SQ_W + l * 144 + m * 2) = f2bf(v); } } \
            SSD_LD(PF, pa, pd, n + 3);     \
            WG_BAR();     } while (0)
        SSD_LD(PFA, paA, pdA, 0); SSD_LD(PFB, paB, pdB, 1);
#pragma unroll 1
        for (int m = -1; m < n_end; m += 2) { SSD_HBODY(m, PFA, paA, pdA); if (m + 1 >= n_end) break; SSD_HBODY(m + 1, PFB, paB, pdB); }
#undef SSD_LD
#undef SSD_HBODY
        return;
    }
    const int pb = w;
    f32x16 st[4];
#pragma unroll
    for (int k = 0; k < 4; ++k) st[k] = zero16();
#pragma unroll 1
    for (int n = -1; n < n_end; ++n) {
        int tid = tid_in; asm volatile("" : "+v"(tid));
        const int lane = tid & 63, r = lane & 31, h = lane >> 5; const bool full = (n >= n_full);
        const LAS unsigned char* Tt = L + (n & 1) * SQ_BUF; const LAS float* acs = (const LAS float*)(Tt + SQ_A);
#define SSD_STATE() do { const float cd = acs[256]; \
            const LAS unsigned char* bp = Tt + SQ_B + (8 * h + ((lane & 15) >> 2)) * 272 + (16 * ((lane >> 4) & 1) + 4 * (lane & 3)) * 2; \
            _Pragma("unroll") for (int kb = 0; kb < 4; ++kb) st[kb] = st[kb] * cd; \
            _Pragma("unroll") for (int ks = 0; ks < 4; ++ks) { const int m0 = ks * 16 + 8 * h; \
                const u16x8 xr = *(const LAS u16x8*)(Tt + SQ_X + (pb * 32 + r) * 144 + m0 * 2); \
                const f32x4_t f0 = *(const LAS f32x4_t*)(acs + 192 + m0), f1 = *(const LAS f32x4_t*)(acs + 196 + m0); \
                const v4u xv = mk4(pk2(bf2f(xr[0]) * f0[0], bf2f(xr[1]) * f0[1]), pk2(bf2f(xr[2]) * f0[2], bf2f(xr[3]) * f0[3]), pk2(bf2f(xr[4]) * f1[0], bf2f(xr[5]) * f1[1]), pk2(bf2f(xr[6]) * f1[2], bf2f(xr[7]) * f1[3])); \
                _Pragma("unroll") for (int kb = 0; kb < 4; ++kb) st[kb] = MFMA32(tr_frag(bp + ks * 16 * 272 + kb * 64, 272), __builtin_bit_cast(bf16x8, xv), st[kb]); } } while (0)
        if (n >= 0 && full) {
            f32x16 y[2];
            v4u cf[16];
#pragma unroll
            for (int i = 0; i < 16; ++i) { const LAS unsigned char* ap = Tt + SQ_C + ((i & 1) * 32 + r) * 272 + ((i >> 1) * 16 + 4 * h) * 2;
                const v2u a0 = *(const LAS v2u*)ap, a1 = *(const LAS v2u*)(ap + 16); cf[i].x = a0.x; cf[i].y = a0.y; cf[i].z = a1.x; cf[i].w = a1.y; }
            const float e0 = acs[128 + r], e1 = acs[160 + r];
            __builtin_amdgcn_sched_barrier(0);
#pragma unroll
            for (int kb = 0; kb < 4; ++kb)
#pragma unroll
                for (int s = 0; s < 2; ++s) { const bf16x8 sa = pack_acc(st[kb], s);
#pragma unroll
                    for (int lb = 0; lb < 2; ++lb) y[lb] = (kb == 0 && s == 0) ? MFMA32(sa, __builtin_bit_cast(bf16x8, cf[lb]), zero16()) : MFMA32(sa, __builtin_bit_cast(bf16x8, cf[(kb * 2 + s) * 2 + lb]), y[lb]); }
            y[0] = y[0] * e0; y[1] = y[1] * e1;
            WG_BAR();
#pragma unroll
            for (int lb = 0; lb < 2; ++lb)
#pragma unroll
                for (int ks = 0; ks < 4; ++ks) { if (ks >= 2 * lb + 2) continue;
                    y[lb] = MFMA32(*(const LAS bf16x8*)(Tt + SQ_X + (pb * 32 + r) * 144 + (ks * 16 + 8 * h) * 2), *(const LAS bf16x8*)(Tt + SQ_W + (lb * 32 + r) * 144 + (ks * 16 + 8 * h) * 2), y[lb]); }
            SSD_STATE();
            if (!dry) store_cols_bf16((bf16_t*)(P.ws + WS_YS) + (rowb + (size_t)n * 64 + r) * 512 + g * 256 + hh * 64 + pb * 32 + 4 * h, 512, y[0], y[1]);
        } else {
            if (n + 1 >= n_full) WG_BAR();
            if (n >= 0) SSD_STATE();
        }
#undef SSD_STATE
        WG_BAR();
    }
}
__device__ __forceinline__ void ssd_norm(const Params& P, int layer, int gt, int ng) {
    bf16_t* proj = (bf16_t*)(P.ws + WS_PROJ);
    for (int it = gt; it < T * 2 * 32; it += ng) { const int item = it >> 5, cg = it & 31, row = item >> 1, g = item & 1;
        bf16_t* yp = proj + (size_t)row * NP + C_SX + g * 256 + cg * 8;
        const u16x8 yv = *(const u16x8*)yp; const u16x8 zv = *(const u16x8*)(proj + (size_t)row * NP + C_SZ + g * 256 + cg * 8);
        float v[8], sq = 0.f;
#pragma unroll
        for (int j = 0; j < 8; ++j) { v[j] = bf2f(yv[j]) * silu_f(bf2f(zv[j])); sq += v[j] * v[j]; }
        sq += __shfl_xor(sq, 1); sq += __shfl_xor(sq, 2); sq += __shfl_xor(sq, 4); sq += __shfl_xor(sq, 8); sq += __shfl_xor(sq, 16);
        const float rs = rsqrt_f(sq * (1.f / 256.f) + NORM_EPS); const float* nwp = P.ssd_norm_w + layer * 512 + g * 256 + cg * 8;
#pragma unroll
        for (int j = 0; j < 8; ++j) v[j] *= rs * nwp[j];
        *(v4u*)yp = mk4(pk2(v[0], v[1]), pk2(v[2], v[3]), pk2(v[4], v[5]), pk2(v[6], v[7])); }
}

constexpr int GREC = 62464, GR_W = 0, GR_QD = 17408, GR_KDT = 34816, GR_A = 53248;
constexpr int GP_Q = 0, GP_K = 17408, GP_KT = 34816, GP_VT = 53248, GP_L = 71680, GP_TU = 88064, GP_TW = 97280, GP_RQ = 106496, GP_RK = 106752, GP_GCS = 107008, GP_BETA = 107264, GP_END = 107520;
__device__ __forceinline__ int swz16(int k) { return (k & ~12) | ((k & 4) << 1) | ((k & 8) >> 1); }
__device__ __forceinline__ void gdn_prep(const Params& P, int layer, int task, LAS unsigned char* L, int tid_in) {
    int tid = tid_in; asm volatile("" : "+v"(tid));
    const bf16_t* proj = (const bf16_t*)(P.ws + WS_PROJ); const float* sm = (const float*)(P.ws + WS_SMALL);
    const int b = task >> 8, hd = (task >> 6) & 3, n = task & 63, t0 = n * 64, lane = tid & 63, w = __builtin_amdgcn_readfirstlane(tid >> 6), r = lane & 31, h = lane >> 5;
    const size_t row0 = (size_t)b * SEQ + t0;
    unsigned char* rec = P.ws + WS_GT + (size_t)task * GREC; unsigned* urec = (unsigned*)(P.ws + WS_XB) + (size_t)task * 4096;
    if (w < 6) {
        const int cgq = tid % 48, tg = tid / 48, type = cgq >> 4, d0 = (cgq & 15) * 8;
        const int col = (type == 0 ? C_GQ : (type == 1 ? C_GK : C_GV)) + hd * 128 + d0, ch = type * 512 + hd * 128 + d0;
        v4u R[11];
#pragma unroll
        for (int j = 0; j < 11; ++j) { const int tokrel = 8 * tg + j - 3; R[j] = (tokrel >= 0 || t0 > 0) ? *(const v4u*)(proj + ((size_t)row0 + tokrel) * NP + col) : mk4(0u, 0u, 0u, 0u); }
        const float* cw = P.gdn_conv_w + (size_t)layer * 4 * 1536 + ch;
        v4u tokv[8];
#pragma unroll
        for (int j = 0; j < 8; ++j) tokv[j] = mk4(0u, 0u, 0u, 0u);
#pragma unroll
        for (int c = 0; c < 8; ++c) { const float w0 = cw[c], w1 = cw[1536 + c], w2 = cw[3072 + c], w3 = cw[4608 + c]; float o[8];
#pragma unroll
            for (int j = 0; j < 8; ++j) o[j] = silu_f(w0 * bfsel(R[j], c) + w1 * bfsel(R[j + 1], c) + w2 * bfsel(R[j + 2], c) + w3 * bfsel(R[j + 3], c));
            const v4u chv = mk4(pk2(o[0], o[1]), pk2(o[2], o[3]), pk2(o[4], o[5]), pk2(o[6], o[7]));
            if (type == 1) *(LAS v4u*)(L + GP_KT + (d0 + c) * 144 + tg * 16) = chv;
            else if (type == 2) *(LAS v4u*)(L + GP_VT + (d0 + c) * 144 + tg * 16) = chv;
            if (type < 2) {
#pragma unroll
                for (int j = 0; j < 8; ++j) { const unsigned hv = (chv[j >> 1] >> (16 * (j & 1))) & 0xffffu; tokv[j][c >> 1] |= hv << (16 * (c & 1)); } } }
        if (type < 2) {
#pragma unroll
            for (int j = 0; j < 8; ++j) *(LAS v4u*)(L + (type == 0 ? GP_Q : GP_K) + (8 * tg + j) * 272 + d0 * 2) = tokv[j]; }
    } else if (w == 6) {
        const float beta = sigmoid_f(sm[(row0 + lane) * 16 + 8 + hd]);
        float c = -__expf(P.gdn_a_log[layer * 4 + hd]) * softplus_f(sm[(row0 + lane) * 16 + 12 + hd] + P.gdn_dt_bias[layer * 4 + hd]);
#pragma unroll
        for (int o = 1; o < 64; o <<= 1) { const float t = __shfl_up(c, o); if (lane >= o) c += t; }
        *(LAS float*)(L + GP_GCS + lane * 4) = c; *(LAS float*)(L + GP_BETA + lane * 4) = beta;
    }
    __syncthreads();
    { const int tok = tid >> 3, part = tid & 7; float sq = 0.f, sk = 0.f;
#pragma unroll
      for (int v = 0; v < 2; ++v) { const u16x8 a = *(const LAS u16x8*)(L + GP_Q + tok * 272 + part * 32 + v * 16), c = *(const LAS u16x8*)(L + GP_K + tok * 272 + part * 32 + v * 16);
#pragma unroll
          for (int j = 0; j < 8; ++j) { const float x = bf2f(a[j]), y = bf2f(c[j]); sq += x * x; sk += y * y; } }
      sq += __shfl_xor(sq, 1); sq += __shfl_xor(sq, 2); sq += __shfl_xor(sq, 4); sk += __shfl_xor(sk, 1); sk += __shfl_xor(sk, 2); sk += __shfl_xor(sk, 4);
      if (part == 0) { *(LAS float*)(L + GP_RQ + tok * 4) = (rsqrt_f(sq + L2_EPS)) * 0.08838834764831845f; *(LAS float*)(L + GP_RK + tok * 4) = rsqrt_f(sk + L2_EPS); } }
    __syncthreads();
    const LAS float* rq = (const LAS float*)(L + GP_RQ); const LAS float* rk = (const LAS float*)(L + GP_RK); const LAS float* gcs = (const LAS float*)(L + GP_GCS); const LAS float* bet = (const LAS float*)(L + GP_BETA);
    const float glast = gcs[63];
    if (w < 6) {
        const int t = (w < 3) ? w : w - 3, ib = (t + 1) >> 1, jb = t >> 1; f32x16 s = zero16();
        mma_nt<8>(s, L + ((w < 3) ? GP_K : GP_Q) + ib * 32 * 272, 272, L + GP_K + jb * 32 * 272, 272, r, h);
        const int jj = jb * 32 + r; const float rkj = rk[jj], gj = gcs[jj];
#pragma unroll
        for (int i = 0; i < 16; ++i) { const int ii = ib * 32 + crow(i, h); const float e = __expf(gcs[ii] - gj) * rkj * s[i];
            if (w < 3) *(LAS float*)(L + GP_L + (ii * 64 + jj) * 4) = (ii > jj) ? e * bet[ii] * rk[ii] : 0.f;
            else *(bf16_t*)(rec + GR_A + ii * 144 + (jb * 32 + swz16(r)) * 2) = f2bf((ii >= jj) ? e * rq[ii] : 0.f); }
    }
    __syncthreads();
    if (w == 0) {
        const int hb = lane >> 5, cc = lane & 31; float tc[32];
        const LAS float* Lb = (const LAS float*)(L + GP_L) + (hb * 32) * 64 + hb * 32;
#pragma unroll
        for (int i = 0; i < 32; ++i) { float a0 = (i == cc) ? 1.f : 0.f, a1 = 0.f;
            if ((i & 3) == 0 && i > 0) { int zz; asm volatile("v_mov_b32 %0, 0" : "=v"(zz) : "v"(tc[i - 1])); Lb += zz; }
#pragma unroll
            for (int j4 = 0; j4 < i; j4 += 4) { const f32x4_t lv = *(const LAS f32x4_t*)(Lb + i * 64 + j4);
                a0 -= lv[0] * tc[j4]; if (j4 + 1 < i) a1 -= lv[1] * tc[j4 + 1]; if (j4 + 2 < i) a0 -= lv[2] * tc[j4 + 2]; if (j4 + 3 < i) a1 -= lv[3] * tc[j4 + 3]; }
            tc[i] = a0 + a1; }
        const float bu = bet[lane], bw = bu * rk[lane] * __expf(gcs[lane]);
#pragma unroll
        for (int i = 0; i < 32; ++i) { const int row = hb * 32 + i;
            *(LAS bf16_t*)(L + GP_TU + row * 144 + lane * 2) = f2bf(tc[i] * bu); *(LAS bf16_t*)(L + GP_TW + row * 144 + lane * 2) = f2bf(tc[i] * bw);
            if (hb == 1) { *(LAS bf16_t*)(L + GP_TU + i * 144 + lane * 2) = 0; *(LAS bf16_t*)(L + GP_TW + i * 144 + lane * 2) = 0; } }
        LAS unsigned char* T11t = L + GP_END; LAS unsigned char* T22r = L + GP_END + 4096;
        if (hb == 0) {
#pragma unroll
            for (int k8 = 0; k8 < 4; ++k8) *(LAS v4u*)(T11t + cc * 80 + k8 * 16) = mk4(pk2(tc[8 * k8], tc[8 * k8 + 1]), pk2(tc[8 * k8 + 2], tc[8 * k8 + 3]), pk2(tc[8 * k8 + 4], tc[8 * k8 + 5]), pk2(tc[8 * k8 + 6], tc[8 * k8 + 7])); }
        else {
#pragma unroll
            for (int i = 0; i < 32; ++i) *(LAS bf16_t*)(T22r + i * 80 + cc * 2) = f2bf(tc[i]); }
        asm volatile("s_waitcnt lgkmcnt(0)" ::: "memory");
        f32x16 X = zero16();
#pragma unroll
        for (int ks = 0; ks < 2; ++ks) { const LAS float* lp = (const LAS float*)(L + GP_L) + (32 + r) * 64 + ks * 16 + 8 * h;
            const f32x4_t l0 = *(const LAS f32x4_t*)lp, l1 = *(const LAS f32x4_t*)(lp + 4);
            const v4u av = mk4(pk2(l0[0], l0[1]), pk2(l0[2], l0[3]), pk2(l1[0], l1[1]), pk2(l1[2], l1[3]));
            X = MFMA32(__builtin_bit_cast(bf16x8, av), *(const LAS bf16x8*)(T11t + r * 80 + ks * 32 + h * 16), X); }
        f32x16 T21 = zero16();
#pragma unroll
        for (int sx = 0; sx < 2; ++sx) { const LAS unsigned char* ap = T22r + r * 80 + (16 * sx + 4 * h) * 2;
            const v2u a0 = *(const LAS v2u*)ap, a1 = *(const LAS v2u*)(ap + 16); v4u av; av.x = a0.x; av.y = a0.y; av.z = a1.x; av.w = a1.y;
            T21 = MFMA32(__builtin_bit_cast(bf16x8, av), pack_acc(X, sx), T21); }
        { const float bu2 = bet[r], bw2 = bu2 * rk[r] * __expf(gcs[r]);
#pragma unroll
          for (int i = 0; i < 16; ++i) { const int row = 32 + crow(i, h);
              *(LAS bf16_t*)(L + GP_TU + row * 144 + r * 2) = f2bf(-T21[i] * bu2); *(LAS bf16_t*)(L + GP_TW + row * 144 + r * 2) = f2bf(-T21[i] * bw2); } }
    }
    else {
        const int lt = tid - 64;
#pragma unroll 1
        for (int it = lt; it < 512; it += 448) { const int c = it >> 3, grp = it & 7;
            const u16x8 a0 = *(const LAS u16x8*)(L + GP_Q + c * 272 + grp * 32), a1 = *(const LAS u16x8*)(L + GP_Q + c * 272 + grp * 32 + 16); const float sc = rq[c] * __expf(gcs[c]);
            const v4u o0 = mk4(pk2(bf2f(a0[0]) * sc, bf2f(a0[1]) * sc), pk2(bf2f(a0[2]) * sc, bf2f(a0[3]) * sc), pk2(bf2f(a1[0]) * sc, bf2f(a1[1]) * sc), pk2(bf2f(a1[2]) * sc, bf2f(a1[3]) * sc));
            const v4u o1 = mk4(pk2(bf2f(a0[4]) * sc, bf2f(a0[5]) * sc), pk2(bf2f(a0[6]) * sc, bf2f(a0[7]) * sc), pk2(bf2f(a1[4]) * sc, bf2f(a1[5]) * sc), pk2(bf2f(a1[6]) * sc, bf2f(a1[7]) * sc));
            *(v4u*)(rec + GR_QD + c * 272 + grp * 32) = o0; *(v4u*)(rec + GR_QD + c * 272 + grp * 32 + 16) = o1; }
#pragma unroll 1
        for (int it = lt; it < 512; it += 448) { const int dk = it >> 2, grp = it & 3;
            const u16x8 a0 = *(const LAS u16x8*)(L + GP_KT + dk * 144 + grp * 32), a1 = *(const LAS u16x8*)(L + GP_KT + dk * 144 + grp * 32 + 16); float f[16];
#pragma unroll
            for (int j = 0; j < 8; ++j) { const int c0 = grp * 16 + j, c1 = c0 + 8; f[j] = bf2f(a0[j]) * rk[c0] * __expf(glast - gcs[c0]); f[8 + j] = bf2f(a1[j]) * rk[c1] * __expf(glast - gcs[c1]); }
            *(v4u*)(rec + GR_KDT + dk * 144 + grp * 32) = mk4(pk2(f[0], f[1]), pk2(f[2], f[3]), pk2(f[8], f[9]), pk2(f[10], f[11]));
            *(v4u*)(rec + GR_KDT + dk * 144 + grp * 32 + 16) = mk4(pk2(f[4], f[5]), pk2(f[6], f[7]), pk2(f[12], f[13]), pk2(f[14], f[15])); }
        if (lt == 0) *(float*)(rec + GR_W + 256) = __expf(glast);
    }
    __syncthreads();
    { const int cb = w >> 2, vs = w & 3; f32x16 u = zero16(), wn = zero16();
      mma_nt<4>(u, L + GP_TU + cb * 32 * 144, 144, L + GP_VT + vs * 32 * 144, 144, r, h);
      mma_nt<4>(wn, L + GP_TW + cb * 32 * 144, 144, L + GP_KT + vs * 32 * 144, 144, r, h);
#pragma unroll
      for (int i = 0; i < 16; ++i) { if ((i & 1) == 0) urec[((vs * 2 + cb) * 8 + (i >> 1)) * 64 + lane] = pk2(u[i], u[i + 1]);
          *(bf16_t*)(rec + GR_W + (cb * 32 + crow(i, h)) * 272 + (vs * 32 + swz16(r)) * 2) = f2bf(-wn[i]); } }
}
constexpr int GS_BUF = 0, GS_END = 2 * GREC;
__device__ __forceinline__ void gdn_dma(const unsigned char* src, LAS unsigned char* dst, int hw, int lane, bool full) {
#pragma unroll
    for (int p = 0; p < 16; ++p) { const int piece = hw + 4 * p; if (piece < GREC / 1024 && (full || piece < GR_QD / 1024 || (piece >= GR_KDT / 1024 && piece < GR_A / 1024)))
        __builtin_amdgcn_global_load_lds((const unsigned*)(src + (size_t)piece * 1024 + lane * 16), (LAS unsigned*)(dst + piece * 1024), 16, 0, 0); }
}
__device__ __forceinline__ void gdn_seq(const Params& P, int layer, int prob, LAS unsigned char* L, int tid_in, bool dry = false) {
    bf16_t* proj = (bf16_t*)(P.ws + WS_PROJ);
    const int seg = prob % NSG, bh = prob / NSG, b = bh >> 2, hd = bh & 3, w = __builtin_amdgcn_readfirstlane(tid_in >> 6);
    const int n_full = gseg_lo(seg), n_end = gseg_lo(seg + 1);
    const unsigned char* rec0 = P.ws + WS_GT + (size_t)(bh * 64) * GREC; const unsigned* urec0 = (const unsigned*)(P.ws + WS_XB) + (size_t)(bh * 64) * 4096;
    if (w >= 4) {
        const int ht = tid_in - 256; v4u RA[16], RB[16];
#define GDN_LD(R, chunk) do { const unsigned char* src_ = rec0 + (size_t)(chunk) * GREC; _Pragma("unroll") for (int q = 0; q < 16; ++q) { const int v = (q < 15) ? ht + 256 * q : min(ht + 3840, GREC / 16 - 1); \
            R[q] = *(const v4u*)(src_ + (size_t)v * 16); } } while (0)
#define GDN_ST(R, chunk) do { LAS unsigned char* dst_ = L + GS_BUF + ((chunk) & 1) * GREC; _Pragma("unroll") for (int q = 0; q < 16; ++q) { const int v = (q < 15) ? ht + 256 * q : min(ht + 3840, GREC / 16 - 1); \
            *(LAS v4u*)(dst_ + v * 16) = R[q]; } } while (0)
        const int last = n_end - 1;
        GDN_LD(RA, 0); GDN_LD(RB, min(1, last));
        GDN_ST(RA, 0); GDN_LD(RA, min(2, last));
        WG_BAR();
#pragma unroll 1
        for (int n = 0; n < n_end; n += 2) {
            GDN_ST(RB, n + 1);
            GDN_LD(RB, min(n + 3, last));
            WG_BAR();
            if (n + 1 >= n_end) break;
            GDN_ST(RA, n + 2);
            GDN_LD(RA, min(n + 4, last));
            WG_BAR();
        }
#undef GDN_LD
#undef GDN_ST
        return;
    }
    f32x16 S[4];
#pragma unroll
    for (int k = 0; k < 4; ++k) S[k] = zero16();
    unsigned ur[16];
    { const int lane = tid_in & 63;
#pragma unroll
      for (int q = 0; q < 16; ++q) ur[q] = urec0[(w * 16 + q) * 64 + lane]; }
    WG_BAR();
#pragma unroll 1
    for (int n = 0; n < n_end; ++n) {
        int tid = tid_in; asm volatile("" : "+v"(tid));
        const int lane = tid & 63, r = lane & 31, h = lane >> 5; const bool full = (n >= n_full);
        {
            const int vs = w; const LAS unsigned char* Tt = L + GS_BUF + (n & 1) * GREC;
            f32x16 vn[2];
#pragma unroll
            for (int cb = 0; cb < 2; ++cb)
#pragma unroll
                for (int i = 0; i < 16; i += 2) { const unsigned uu = ur[cb * 8 + (i >> 1)]; vn[cb][i] = __uint_as_float(uu << 16); vn[cb][i + 1] = __uint_as_float(uu & 0xffff0000u); }
            if (n + 1 < n_end) { const unsigned* up = urec0 + (size_t)(n + 1) * 4096;
#pragma unroll
                for (int q = 0; q < 16; ++q) ur[q] = up[(vs * 16 + q) * 64 + lane]; }
            bf16x8 vb[2][2];
#define GDN_STATE() do { const float dec = *(const LAS float*)(Tt + GR_W + 256); \
            _Pragma("unroll") for (int kb = 0; kb < 4; ++kb) { S[kb] = S[kb] * dec; \
                _Pragma("unroll") for (int cb = 0; cb < 2; ++cb) \
                    _Pragma("unroll") for (int s = 0; s < 2; ++s) S[kb] = MFMA32(*(const LAS bf16x8*)(Tt + GR_KDT + (kb * 32 + r) * 144 + (cb * 32 + 16 * s + 8 * h) * 2), vb[cb][s], S[kb]); } } while (0)
            f32x16 o[2]; o[0] = zero16(); o[1] = zero16();
#pragma unroll
            for (int kb = 0; kb < 4; ++kb)
#pragma unroll
                for (int s = 0; s < 2; ++s) { const bf16x8 sb = pack_acc(S[kb], s);
#pragma unroll
                    for (int cb = 0; cb < 2; ++cb) { const int off = (cb * 32 + r) * 272 + (kb * 32 + 16 * s + 8 * h) * 2;
                        vn[cb] = MFMA32(*(const LAS bf16x8*)(Tt + GR_W + off), sb, vn[cb]);
                        if (full) o[cb] = MFMA32(sb, *(const LAS bf16x8*)(Tt + GR_QD + off), o[cb]); } }
#pragma unroll
            for (int cb = 0; cb < 2; ++cb)
#pragma unroll
                for (int s = 0; s < 2; ++s) vb[cb][s] = pack_acc(vn[cb], s);
            if (full) {
#pragma unroll
                for (int c2 = 0; c2 < 2; ++c2)
#pragma unroll
                    for (int cb = 0; cb <= c2; ++cb)
#pragma unroll
                        for (int s = 0; s < 2; ++s) o[c2] = MFMA32(vb[cb][s], *(const LAS bf16x8*)(Tt + GR_A + (c2 * 32 + r) * 144 + (cb * 32 + 16 * s + 8 * h) * 2), o[c2]);
            }
            GDN_STATE();
            if (!dry && full) store_cols_bf16(proj + ((size_t)b * SEQ + (size_t)n * 64 + r) * NP + C_GV + hd * 128 + vs * 32 + 4 * h, NP, o[0], o[1]);
#undef GDN_STATE
        }
        WG_BAR();
    }
}

__device__ __forceinline__ void mix_norm(const Params& P, int layer, int gw, int NGW, int lane) {
    bf16_t* proj = (bf16_t*)(P.ws + WS_PROJ);
    float nwr[8], nws[8], nwg[8];
#pragma unroll
    for (int j = 0; j < 8; ++j) { nwr[j] = P.ret_norm_w[layer * 512 + lane * 8 + j]; nws[j] = P.ssd_norm_w[layer * 512 + lane * 8 + j]; nwg[j] = P.gdn_norm_w[layer * 128 + (lane & 15) * 8 + j]; }
#pragma unroll 2
    for (int row = gw; row < T; row += NGW) { bf16_t* pr = proj + (size_t)row * NP + lane * 8;
        const bf16_t* ysr = (const bf16_t*)(P.ws + WS_YS) + (size_t)row * 512 + lane * 8;
        const v4u yr = *(const v4u*)(pr + C_RQ), zr = *(const v4u*)(pr + C_RG), ys = *(const v4u*)ysr, zs = *(const v4u*)(pr + C_SZ), yg = *(const v4u*)(pr + C_GV), zg = *(const v4u*)(pr + C_GZ);
        float a[8], c[8], d[8], qa = 0.f, qc = 0.f, qd = 0.f;
#pragma unroll
        for (int j = 0; j < 8; ++j) { a[j] = bfsel(yr, j); qa += a[j] * a[j]; c[j] = bfsel(ys, j) * silu_f(bfsel(zs, j)); qc += c[j] * c[j]; d[j] = bfsel(yg, j); qd += d[j] * d[j]; }
#pragma unroll
        for (int o = 1; o < 16; o <<= 1) { qa += __shfl_xor(qa, o); qc += __shfl_xor(qc, o); qd += __shfl_xor(qd, o); }
        qc += __shfl_xor(qc, 16);
        const float ra = rsqrt_f(qa * (1.f / 128.f) + NORM_EPS), rc = rsqrt_f(qc * (1.f / 256.f) + NORM_EPS), rd = rsqrt_f(qd * (1.f / 128.f) + NORM_EPS);
#pragma unroll
        for (int j = 0; j < 8; ++j) { a[j] = a[j] * ra * nwr[j] * silu_f(bfsel(zr, j)); c[j] = c[j] * rc * nws[j]; d[j] = d[j] * rd * nwg[j] * silu_f(bfsel(zg, j)); }
        *(v4u*)(pr + C_RV) = mk4(pk2(a[0], a[1]), pk2(a[2], a[3]), pk2(a[4], a[5]), pk2(a[6], a[7]));
        *(v4u*)(pr + C_SX) = mk4(pk2(c[0], c[1]), pk2(c[2], c[3]), pk2(c[4], c[5]), pk2(c[6], c[7]));
        *(v4u*)(pr + C_GV) = mk4(pk2(d[0], d[1]), pk2(d[2], d[3]), pk2(d[4], d[5]), pk2(d[6], d[7])); }
}

struct Args { Params P; };
typedef const __attribute__((address_space(4))) Params* kparams_t;
__device__ __forceinline__ Params load_params() {
#if defined(__HIP_DEVICE_COMPILE__)
    kparams_t kp = (kparams_t)__builtin_amdgcn_kernarg_segment_ptr(); asm volatile("" : "+s"(kp));
    Params r; r.x = kp->x; r.pos = kp->pos; r.mix_norm_w = kp->mix_norm_w; r.w_in = kp->w_in; r.ret_norm_w = kp->ret_norm_w; r.ssd_conv_w = kp->ssd_conv_w; r.ssd_conv_b = kp->ssd_conv_b; r.ssd_dt_bias = kp->ssd_dt_bias;
    r.ssd_a_log = kp->ssd_a_log; r.ssd_d = kp->ssd_d; r.ssd_norm_w = kp->ssd_norm_w; r.gdn_conv_w = kp->gdn_conv_w; r.gdn_dt_bias = kp->gdn_dt_bias; r.gdn_a_log = kp->gdn_a_log; r.gdn_norm_w = kp->gdn_norm_w;
    r.w_out = kp->w_out; r.mlp_norm_w = kp->mlp_norm_w; r.w_up = kp->w_up; r.w_down = kp->w_down; r.final_norm_w = kp->final_norm_w; r.out = kp->out; r.ws = kp->ws; return r;
#else
    return Params{};
#endif
}

#define PHASE_FN __device__ __forceinline__ void
#define PHASE_PRO() extern __shared__ __attribute__((aligned(16))) unsigned char lds[]; LAS unsigned char* L = (LAS unsigned char*)lds; \
    int tid = threadIdx.x; asm volatile("" : "+v"(tid)); const int lane = tid & 63, wave = __builtin_amdgcn_readfirstlane(tid >> 6); const int G = gridDim.x, bx = blockIdx.x; \
    const int vcu = (G % 8 == 0) ? (bx % 8) * (G / 8) + bx / 8 : bx; const int gw = vcu * NWAVES + wave, NGW = G * NWAVES; LAS float* scr = (LAS float*)(L + RING_OFF + wave * 16384); \
    const Params P = load_params(); (void)lane; (void)gw; (void)NGW; (void)scr; (void)vcu; (void)L
#define ssa ((float*)(P.ws + WS_SSA))
#define ssb ((float*)(P.ws + WS_SSB))
#define sm ((float*)(P.ws + WS_SMALL))
#define xb ((bf16_t*)(P.ws + WS_XB))
#define proj ((bf16_t*)(P.ws + WS_PROJ))

PHASE_FN ph_grid_bar() {
    extern __shared__ __attribute__((aligned(16))) unsigned char lds[]; LAS unsigned char* L = (LAS unsigned char*)lds;
    XcdBarrier b_; b_.bar = (unsigned*)(load_params().ws + WS_CTL) + CW_BAR; b_.x = xb_xcc_id(); b_.st = (volatile LAS unsigned*)(L + MISC_OFF) + 8; xcd_barrier(b_);
}
PHASE_FN ph_p0() {
    PHASE_PRO();
    float* cs = (float*)(P.ws + WS_COS); float* sn = (float*)(P.ws + WS_SIN);
    const int gt = bx * (NWAVES * 64) + tid, ng = G * NWAVES * 64;
    for (int i = gt; i < T * 64; i += ng) {
        const int row = i >> 6, f = i & 63;
        const float inv = exp2f(-(float)f * (13.287712379549449f / 64.f));
        const float ang = (float)P.pos[row] * inv;
        double rev = (double)ang * 0.15915494309189535; rev -= floor(rev);
        const float r = (float)rev;
        cs[i] = __builtin_amdgcn_cosf(r); sn[i] = __builtin_amdgcn_sinf(r);
    }
    for (int row = gw; row < T; row += NGW) {
        const float* xr = P.x + (size_t)row * DM; float s = 0.f;
#pragma unroll
        for (int j = 0; j < DM / 256; ++j) { const float4 v = *(const float4*)(xr + j * 256 + lane * 4); s += (v.x * v.x + v.y * v.y) + (v.z * v.z + v.w * v.w);
            uint2 w; w.x = pk2(v.x, v.y); w.y = pk2(v.z, v.w); *(uint2*)(xb + (size_t)row * DM + j * 256 + lane * 4) = w; }
#pragma unroll
        for (int o = 1; o < 64; o <<= 1) s += __shfl_xor(s, o);
        if (lane < 16) ssb[(size_t)row * 16 + lane] = (lane == 0) ? s : 0.f;
    }
    convert_layer_weights(P, 0, scr, gw, NGW, lane, 1);
}
PHASE_FN ph_g1(int l) {
    PHASE_PRO(); unsigned char* wset = P.ws + WS_W + (size_t)(l & 1) * WSET;
    pg8::Gemm g{xb, (const bf16_t*)(wset + W_IN), T, NPX, DM, DM}; pg8::StaticOrder S; S.init(T, NPX, G, bx);
    pg8::EpiScaleBf16<0> E{proj, NP, ssb, (bf16_t*)(P.ws + WS_HALO), sm};
    pg8::gemm_phase<pg8::EpiScaleBf16<0>, pg8::StaticOrder, true, true>(L + RING_OFF, g, S, E);
}
PHASE_FN ph_m1(int l) {
    PHASE_PRO();
    for (int task = bx; task < NB * 4 * 64; task += G) { gdn_prep(P, l, task, L, tid); __syncthreads(); }
    for (int task = bx; task < NB * 2 * 64; task += G) { ssd_prep(P, l, task, tid); __syncthreads(); }
    for (int task = bx; task < NB * 4 * 64; task += G) { ret_prep_vt(P, task, tid); __syncthreads(); }
    ret_prep_rot(P, bx * (NWAVES * 64) + tid, G * NWAVES * 64);
}
PHASE_FN ph_m2_ret(int l) { PHASE_PRO(); ret_seq(P, l, bx, L, tid); }
PHASE_FN ph_m2_gdn(int l) { PHASE_PRO(); gdn_seq(P, l, bx - WG_RET, L, tid); }
PHASE_FN ph_m2_ssd(int l) { PHASE_PRO(); ssd_seq(P, l, bx - WG_RET - WG_GDN, L, tid); }
PHASE_FN ph_m3(int l) { PHASE_PRO(); mix_norm(P, l, gw, NGW, lane); }
PHASE_FN ph_m2_conv(int l) { PHASE_PRO(); if (l == 0) convert_layer_weights(P, 0, scr, (bx - WG_SEQ) * NWAVES + wave, (G - WG_SEQ) * NWAVES, lane, 2);
    if (l + 1 < DEPTH) convert_layer_weights(P, l + 1, scr, (bx - WG_SEQ) * NWAVES + wave, (G - WG_SEQ) * NWAVES, lane); }
PHASE_FN ph_g2(int l) {
    PHASE_PRO(); unsigned char* wset = P.ws + WS_W + (size_t)(l & 1) * WSET;
    pg8::Gemm g{proj + C_RV, (const bf16_t*)(wset + W_OUT), T, DM, MIXW, NP}; pg8::StaticOrder S; S.init(T, DM, G, bx);
    pg8::EpiRes E{(l == 0) ? P.x : (const float*)P.out, P.out, xb, ssa};
    pg8::gemm_phase<pg8::EpiRes, pg8::StaticOrder, true, true>(L + RING_OFF, g, S, E);
}
PHASE_FN ph_g3(int l) {
    PHASE_PRO(); unsigned char* wset = P.ws + WS_W + (size_t)(l & 1) * WSET;
    pg8::Gemm g{xb, (const bf16_t*)(wset + W_UP), T, DFF, DM, DM}; pg8::StaticOrder S; S.init(T, DFF, G, bx);
    pg8::EpiScaleBf16<1> E{proj, DFF, ssa, nullptr, nullptr};
    pg8::gemm_phase<pg8::EpiScaleBf16<1>, pg8::StaticOrder, true, true>(L + RING_OFF, g, S, E);
}
PHASE_FN ph_g4(int l) {
    PHASE_PRO(); unsigned char* wset = P.ws + WS_W + (size_t)(l & 1) * WSET;
    pg8::Gemm g{proj, (const bf16_t*)(wset + W_DOWN), T, DM, DFF, DFF}; pg8::StaticOrder S; S.init(T, DM, G, bx);
    pg8::EpiRes E{(const float*)P.out, P.out, xb, ssb};
    pg8::gemm_phase<pg8::EpiRes, pg8::StaticOrder, true, true>(L + RING_OFF, g, S, E);
}
PHASE_FN ph_final() {
    PHASE_PRO();
    for (int row = gw; row < T; row += NGW) {
        const float rs = row_rs(ssb, row); float* xr = P.out + (size_t)row * DM;
#pragma unroll
        for (int j = 0; j < DM / 256; ++j) { float4 v = *(float4*)(xr + j * 256 + lane * 4); const float4 w = *(const float4*)(P.final_norm_w + j * 256 + lane * 4);
            v.x *= rs * w.x; v.y *= rs * w.y; v.z *= rs * w.z; v.w *= rs * w.w; *(float4*)(xr + j * 256 + lane * 4) = v; }
    }
}
#undef ssa
#undef ssb
#undef sm
#undef xb
#undef proj


__device__ __forceinline__ void layer_body(const int l, const int bx) {
    ph_g1(l); ph_grid_bar();
    ph_m1(l); ph_grid_bar();
    if (bx < WG_RET) ph_m2_ret(l); else if (bx < WG_RET + WG_GDN) ph_m2_gdn(l); else if (bx < WG_SEQ) ph_m2_ssd(l); else if (l + 1 < DEPTH || l == 0) ph_m2_conv(l);
    ph_grid_bar();
    ph_m3(l); ph_grid_bar();
    ph_g2(l); ph_grid_bar();
    ph_g3(l); ph_grid_bar();
    ph_g4(l); ph_grid_bar();
}
__global__ void __launch_bounds__(NWAVES * 64, 2) fwd_mega(Params Pk_unused) {
    extern __shared__ __attribute__((aligned(16))) unsigned char lds[];
    LAS unsigned char* L = (LAS unsigned char*)lds;
    for (int u = threadIdx.x; u < (LDS_BYTES - LDSCTL_OFF) / 4; u += NWAVES * 64) ((LAS unsigned*)(L + LDSCTL_OFF))[u] = 0u;
    __syncthreads();
    (void)xcd_barrier_post((unsigned*)(load_params().ws + WS_CTL) + CW_BAR, (volatile LAS unsigned*)(L + MISC_OFF) + 8);
    ph_p0();
    cg::this_grid().sync();
    const int bx = blockIdx.x;
    layer_body(0, bx); layer_body(1, bx); layer_body(2, bx); layer_body(3, bx);
    ph_final();
}

extern "C" void kernel_launch(void* const* d_in, const int* in_sizes, int n_in, void* d_out, int out_size, void* d_ws, size_t ws_size, hipStream_t stream) {
    static int grid = 0;
    if (grid == 0) {
        if (n_in != 20 || out_size != T * DM || ws_size < WS_END) { fprintf(stderr, "kernel_launch: unexpected shapes n_in=%d out=%d ws=%zu (need %zu)\n", n_in, out_size, ws_size, (size_t)WS_END); grid = -1; return; }
        int dev = 0, cus = 0, per_cu = 0;
        (void)hipGetDevice(&dev); (void)hipDeviceGetAttribute(&cus, hipDeviceAttributeMultiprocessorCount, dev);
        if (hipFuncSetAttribute((const void*)fwd_mega, hipFuncAttributeMaxDynamicSharedMemorySize, LDS_BYTES) != hipSuccess) { fprintf(stderr, "kernel_launch: hipFuncSetAttribute failed\n"); grid = -1; return; }
        if (hipOccupancyMaxActiveBlocksPerMultiprocessor(&per_cu, (const void*)fwd_mega, NWAVES * 64, LDS_BYTES) != hipSuccess || per_cu < 1) { fprintf(stderr, "kernel_launch: occupancy query says %d blocks/CU\n", per_cu); (void)hipGetLastError(); grid = -1; return; }
        grid = cus;
        if (grid % 8 != 0 || grid < 64) fprintf(stderr, "kernel_launch: note: %d CUs\n", grid);
    }
    if (grid < 0) return;
    Params P{};
    P.x = (const float*)d_in[0]; P.pos = (const int*)d_in[1]; P.mix_norm_w = (const float*)d_in[2]; P.w_in = (const float*)d_in[3]; P.ret_norm_w = (const float*)d_in[4];
    P.ssd_conv_w = (const float*)d_in[5]; P.ssd_conv_b = (const float*)d_in[6]; P.ssd_dt_bias = (const float*)d_in[7]; P.ssd_a_log = (const float*)d_in[8]; P.ssd_d = (const float*)d_in[9];
    P.ssd_norm_w = (const float*)d_in[10]; P.gdn_conv_w = (const float*)d_in[11]; P.gdn_dt_bias = (const float*)d_in[12]; P.gdn_a_log = (const float*)d_in[13]; P.gdn_norm_w = (const float*)d_in[14];
    P.w_out = (const float*)d_in[15]; P.mlp_norm_w = (const float*)d_in[16]; P.w_up = (const float*)d_in[17]; P.w_down = (const float*)d_in[18]; P.final_norm_w = (const float*)d_in[19];
    P.out = (float*)d_out; P.ws = (unsigned char*)d_ws;
    if (hipMemsetAsync((char*)d_ws + WS_CTL, 0, CTL_ZERO_BYTES, stream) != hipSuccess) { fprintf(stderr, "kernel_launch: memset failed\n"); return; }
    void* args[] = {&P};
    hipError_t e = hipLaunchCooperativeKernel((const void*)fwd_mega, dim3(grid), dim3(NWAVES * 64), args, LDS_BYTES, stream);
    if (e != hipSuccess) fprintf(stderr, "kernel_launch: cooperative launch failed: %s (grid %d)\n", hipGetErrorString(e), grid);
}
```

```cpp
#include <hip/hip_runtime.h>
#include <hip/hip_cooperative_groups.h>
#include <cstdint>
#include <cstdio>
namespace cg = cooperative_groups;

typedef unsigned short bf16_t;

constexpr int NB = 4, SEQ = 4096, DM = 1024, T = NB * SEQ, DEPTH = 4;
constexpr int DIN = 5648, NP = 5632, NPX = 5888, NSMALL = 16, DFF = 4096, MIXW = 1536;
constexpr float NORM_EPS = 1e-6f, L2_EPS = 1e-6f;
constexpr int C_RQ = 0, C_RK = 512, C_RG = 1024, C_SZ = 1536, C_SB = 2048, C_SC = 2304, C_GQ = 2560, C_GK = 3072, C_GZ = 3584,
              C_RV = 4096, C_SX = 4608, C_GV = 5120;
constexpr size_t MiB = 1u << 20;
constexpr size_t WS_CTL = 0;
constexpr size_t WS_SSA = 1 * MiB;
constexpr size_t WS_SSB = 2 * MiB;
constexpr size_t WS_SMALL = 3 * MiB;
constexpr size_t WS_COS = 4 * MiB, WS_SIN = 8 * MiB;
constexpr size_t WS_W = 12 * MiB;
constexpr size_t WSET = 31 * MiB;
constexpr size_t W_IN = 0, W_OUT = 12 * MiB, W_UP = 15 * MiB, W_DOWN = 23 * MiB;
constexpr size_t WS_XB = 74 * MiB;
constexpr size_t WS_YS = 90 * MiB;
constexpr size_t WS_PROJ = 106 * MiB;
constexpr size_t WS_GT = 282 * MiB;
constexpr size_t WS_HALO = 343 * MiB;
constexpr size_t WS_ACS = 345 * MiB;
constexpr size_t WS_END = 346 * MiB;

struct Params {
    const float* x; const int* pos; const float* mix_norm_w; const float* w_in; const float* ret_norm_w;
    const float* ssd_conv_w; const float* ssd_conv_b; const float* ssd_dt_bias; const float* ssd_a_log; const float* ssd_d; const float* ssd_norm_w;
    const float* gdn_conv_w; const float* gdn_dt_bias; const float* gdn_a_log; const float* gdn_norm_w;
    const float* w_out; const float* mlp_norm_w; const float* w_up; const float* w_down; const float* final_norm_w;
    float* out; unsigned char* ws;
};

__device__ __forceinline__ float bf2f(bf16_t v) { return __uint_as_float((unsigned)v << 16); }
typedef float f32x2_c __attribute__((ext_vector_type(2)));
typedef __bf16 bf16x2_c __attribute__((ext_vector_type(2)));
__device__ __forceinline__ unsigned pk2(float lo, float hi) { f32x2_c v; v.x = lo; v.y = hi; return __builtin_bit_cast(unsigned, __builtin_convertvector(v, bf16x2_c)); }
__device__ __forceinline__ bf16_t f2bf(float f) { return (bf16_t)(pk2(f, f) & 0xffffu); }
__device__ __forceinline__ float silu_f(float x) { return x * __builtin_amdgcn_rcpf(1.f + __expf(-x)); }
__device__ __forceinline__ float sigmoid_f(float x) { return __builtin_amdgcn_rcpf(1.f + __expf(-x)); }
__device__ __forceinline__ float rsqrt_f(float x) { return __builtin_amdgcn_rsqf(x); }
__device__ __forceinline__ float softplus_f(float x) { return fmaxf(x, 0.f) + log1pf(__expf(-fabsf(x))); }
__device__ __forceinline__ float row_rs(const float* ssp, int row) {
    const float4* p = (const float4*)(ssp + (size_t)row * 16); const float4 a = p[0], b = p[1], c = p[2], d = p[3];
    const float s = ((a.x + a.y) + (a.z + a.w)) + ((b.x + b.y) + (b.z + b.w)) + (((c.x + c.y) + (c.z + c.w)) + ((d.x + d.y) + (d.z + d.w)));
    return rsqrt_f(s * (1.f / DM) + NORM_EPS);
}

__host__ __device__ __forceinline__ int c_new2orig(int c) {
    if (c < 1024) return c;
    if (c < 1536) return c - 1024 + 1536;
    if (c < 2048) return c - 1536 + 2048;
    if (c < 2560) return c - 2048 + 3072;
    if (c < 3584) return c - 2560 + 3592;
    if (c < 4096) return c - 3584 + 5128;
    if (c < 4608) return c - 4096 + 1024;
    if (c < 5120) return c - 4608 + 2560;
    if (c < 5632) return c - 5120 + 4616;
    if (c < 5640) return c - 5632 + 3584;
    return c - 5640 + 5640;
}


namespace pg8 {
#define PG8_LAS __attribute__((address_space(3)))
typedef unsigned short bf16_t;
typedef short bf16x8 __attribute__((ext_vector_type(8)));
typedef float f32x4 __attribute__((ext_vector_type(4)));
typedef unsigned u32x4 __attribute__((ext_vector_type(4)));
constexpr int BM = 256, BK = 64, HALF = 128, HTB = HALF * BK * 2  , STAGE_BYTES = 8 * HTB, NXCD = 8, WGM = 4;

__host__ __device__ __forceinline__ int lds_byte(int r, int c) { const int st = (r >> 4) * 2 + (c >> 5), rr = r & 15, cc = c & 31, ob = rr * 64 + cc * 2; return st * 1024 + (ob ^ (((ob >> 9) & 1) << 5)); }
__host__ __device__ __forceinline__ void stage_rc(int b, int& R, int& C) { const int st = b / 1024, sb = b % 1024, swz = sb ^ (((sb >> 9) & 1) << 5); R = (st >> 1) * 16 + swz / 64; C = (st & 1) * 32 + (swz % 64) / 2; }
__host__ __device__ __forceinline__ int perm32(int rho) { const int n = rho >> 4, i = rho & 15; return 8 * (i >> 2) + 4 * n + (i & 3); }

struct Unit { int pm, pn; };
struct Gemm { const bf16_t* A; const bf16_t* Bt; int M, N, K, lda; };

struct StaticOrder {
    int nM, nN, nwg, G, c;
    __host__ __device__ void init(int M, int N, int G_, int c_) { nM = M / BM; nN = N / BM; nwg = nM * nN; G = G_; c = c_; }
    __host__ __device__ bool next(int i, Unit& u) const {
        const long L = (long)i * G + c; if (L >= nwg) return false;
        int wgid = (int)L; { const int q = nwg / NXCD, r = nwg % NXCD, xcd = wgid % NXCD, off = wgid / NXCD; wgid = (xcd < r ? xcd * (q + 1) : r * (q + 1) + (xcd - r) * q) + off; }
        const int nig = WGM * nN, gid = wgid / nig, fm = gid * WGM, gsz = (nM - fm) < WGM ? (nM - fm) : WGM;
        u.pm = fm + ((wgid % nig) % gsz); u.pn = (wgid % nig) / gsz; return true;
    }
    __device__ __forceinline__ void a_ready(const Unit&) const {}
    __device__ __forceinline__ void done(const Unit&) const {}
};

__device__ __forceinline__ unsigned cvt_pk_bf16(float lo, float hi) { unsigned r; asm volatile("v_cvt_pk_bf16_f32 %0, %1, %2" : "=v"(r) : "v"(lo), "v"(hi)); return r; }
typedef float f32x2 __attribute__((ext_vector_type(2)));
template <class Epi, class Sched, bool ALIGN_EPI = false, bool SP2 = false>
__device__ __forceinline__ void gemm_phase(PG8_LAS unsigned char* lds, const Gemm g, const Sched& S, const Epi& E) {
    int tid_l = threadIdx.x; asm volatile("" : "+v"(tid_l));
    const int tid = tid_l, wid = __builtin_amdgcn_readfirstlane(tid >> 6), lane = tid & 63, wr = wid >> 2, wc = wid & 3, fr = lane & 15, fq = lane >> 4;
    const int K = g.K, nt = K / BK;
    unsigned voffA[2], voffB[2];
#pragma unroll
    for (int i = 0; i < 2; ++i) { int R, C; stage_rc(tid * 16 + i * 8192, R, C); const int Rb = Epi::PERM ? ((R & ~31) + perm32(R & 31)) : R;
        voffA[i] = (unsigned)(R * g.lda + C) * 2u; voffB[i] = (unsigned)(Rb * K + C) * 2u; }
    const size_t kstep = (size_t)(BK * 2);
    const size_t hstepA = (size_t)HALF * g.lda * 2, hstepB = (size_t)HALF * K * 2;
    const size_t tstepA = 2 * hstepA, tstepB = 2 * hstepB;
    const unsigned ldsw = (unsigned)wid * 1024u;
    const int aoff = lds_byte(wr * 64 + fr, fq * 8), boff = lds_byte(wc * 32 + fr, fq * 8);
#define PG8_SA(b, h) (((b) * 2 + (h)) * HTB)
#define PG8_SB(b, h) ((4 + (b) * 2 + (h)) * HTB)
#define PG8_STAGE(bufoff, gbase, voff) do { _Pragma("unroll") for (int _i = 0; _i < 2; ++_i) \
        __builtin_amdgcn_global_load_lds((const unsigned*)((const char*)(gbase) + (voff)[_i]), (PG8_LAS unsigned*)(lds + (bufoff) + ldsw + _i * 8192), 16, 0, 0); } while (0)
#define PG8_LDA(dst, b, h) do { _Pragma("unroll") for (int m = 0; m < 4; ++m) _Pragma("unroll") for (int k = 0; k < 2; ++k) dst[m][k] = *(const PG8_LAS bf16x8*)(lds + PG8_SA(b, h) + aoff + m * 2048 + k * 1024); } while (0)
#define PG8_LDB(dst, b, h) do { _Pragma("unroll") for (int n = 0; n < 2; ++n) _Pragma("unroll") for (int k = 0; k < 2; ++k) dst[n][k] = *(const PG8_LAS bf16x8*)(lds + PG8_SB(b, h) + boff + n * 2048 + k * 1024); } while (0)
#define PG8_MMA(ai, bj, At, Bt) do { __builtin_amdgcn_s_setprio(1); _Pragma("unroll") for (int m = 0; m < 4; ++m) _Pragma("unroll") for (int n = 0; n < 2; ++n) _Pragma("unroll") for (int k = 0; k < 2; ++k) \
        acc[ai][bj][m][n] = __builtin_amdgcn_mfma_f32_16x16x32_bf16(Bt[n][k], At[m][k], acc[ai][bj][m][n], 0, 0, 0); __builtin_amdgcn_s_setprio(0); } while (0)
#define PG8_WAIT_V(n) asm volatile("s_waitcnt vmcnt(" #n ")" ::: "memory")
#define PG8_WAIT_L(n) asm volatile("s_waitcnt lgkmcnt(" #n ")" ::: "memory")
#define PG8_BAR __builtin_amdgcn_s_barrier()
#define PG8_SCHED __builtin_amdgcn_sched_barrier(0)
    Unit cur, nxt; int ui = 0;
    if (!S.next(0, cur)) return;
    f32x4 acc[2][2][4][2];
#pragma unroll
    for (int a = 0; a < 2; ++a)
#pragma unroll
        for (int b = 0; b < 2; ++b)
#pragma unroll
            for (int m = 0; m < 4; ++m)
#pragma unroll
                for (int n = 0; n < 2; ++n) acc[a][b][m][n] = (f32x4){0.f, 0.f, 0.f, 0.f};
    bf16x8 At[4][2], B0[2][2], B1[2][2];
    const char* cA = (const char*)g.A + (size_t)cur.pm * tstepA; const char* cB = (const char*)g.Bt + (size_t)cur.pn * tstepB;
    S.a_ready(cur);
    if constexpr (SP2) {
        PG8_STAGE(PG8_SB(0, 0), cB, voffB); PG8_STAGE(PG8_SB(0, 1), cB + hstepB, voffB); PG8_STAGE(PG8_SA(0, 0), cA, voffA); PG8_STAGE(PG8_SA(0, 1), cA + hstepA, voffA);
        if (wr == 1) PG8_BAR;
        PG8_WAIT_V(2); PG8_BAR;
        PG8_STAGE(PG8_SB(1, 0), cB + kstep, voffB); PG8_STAGE(PG8_SA(1, 0), cA + kstep, voffA); PG8_STAGE(PG8_SB(1, 1), cB + hstepB + kstep, voffB);
        PG8_WAIT_V(6); PG8_BAR;
    } else {
        PG8_STAGE(PG8_SB(0, 0), cB, voffB); PG8_STAGE(PG8_SA(0, 0), cA, voffA); PG8_STAGE(PG8_SB(0, 1), cB + hstepB, voffB); PG8_STAGE(PG8_SA(0, 1), cA + hstepA, voffA);
        if (wr == 1) PG8_BAR;
        PG8_WAIT_V(4); PG8_BAR;
        PG8_STAGE(PG8_SB(1, 0), cB + kstep, voffB); PG8_STAGE(PG8_SA(1, 0), cA + kstep, voffA); PG8_STAGE(PG8_SB(1, 1), cB + hstepB + kstep, voffB);
        PG8_WAIT_V(6); PG8_BAR;
    }
    for (;;) {
        const bool has_next = S.next(ui + 1, nxt);
        const char* nA = has_next ? (const char*)g.A + (size_t)nxt.pm * tstepA : cA; const char* nB = has_next ? (const char*)g.Bt + (size_t)nxt.pn * tstepB : cB;
        for (int t = 0; t < nt; t += 2) {
            const bool last = (t == nt - 2);
            const char* a1 = cA + (size_t)(t + 1) * kstep;
            const char* a2 = last ? nA : cA + (size_t)(t + 2) * kstep; const char* b2 = last ? nB : cB + (size_t)(t + 2) * kstep;
            const char* a3 = a2 + kstep; const char* b3 = b2 + kstep;
            if (last && has_next) S.a_ready(nxt);
            if constexpr (SP2) {
            PG8_LDB(B0, 0, 0); PG8_LDB(B1, 0, 1); PG8_SCHED; PG8_LDA(At, 0, 0); PG8_STAGE(PG8_SA(1, 1), a1 + hstepA, voffA);
            PG8_WAIT_V(8); PG8_WAIT_L(0); PG8_BAR; PG8_MMA(0, 0, At, B0); PG8_MMA(0, 1, At, B1); PG8_BAR; PG8_SCHED;
            PG8_LDA(At, 0, 1); PG8_STAGE(PG8_SB(0, 0), b2, voffB); PG8_STAGE(PG8_SB(0, 1), b2 + hstepB, voffB); PG8_STAGE(PG8_SA(0, 0), a2, voffA);
            PG8_WAIT_V(8); PG8_WAIT_L(0); PG8_BAR; PG8_MMA(1, 0, At, B0); PG8_MMA(1, 1, At, B1); PG8_BAR; PG8_SCHED;
            PG8_LDB(B0, 1, 0); PG8_LDB(B1, 1, 1); PG8_SCHED; PG8_LDA(At, 1, 0); PG8_STAGE(PG8_SA(0, 1), a2 + hstepA, voffA);
            PG8_WAIT_V(8); PG8_WAIT_L(0); PG8_BAR; PG8_MMA(0, 0, At, B0); PG8_MMA(0, 1, At, B1); PG8_BAR; PG8_SCHED;
            PG8_LDA(At, 1, 1); PG8_STAGE(PG8_SB(1, 0), b3, voffB); PG8_STAGE(PG8_SB(1, 1), b3 + hstepB, voffB); PG8_STAGE(PG8_SA(1, 0), a3, voffA);
            PG8_WAIT_V(8); PG8_WAIT_L(0); PG8_BAR; PG8_MMA(1, 0, At, B0); PG8_MMA(1, 1, At, B1); PG8_BAR; PG8_SCHED;
            } else {
            PG8_LDB(B0, 0, 0); PG8_SCHED; PG8_LDA(At, 0, 0); PG8_STAGE(PG8_SA(1, 1), a1 + hstepA, voffA);
            PG8_WAIT_L(8); PG8_BAR; PG8_WAIT_L(0); PG8_MMA(0, 0, At, B0); PG8_BAR; PG8_SCHED;
            PG8_LDB(B1, 0, 1); PG8_STAGE(PG8_SB(0, 0), b2, voffB);
            PG8_BAR; PG8_WAIT_L(0); PG8_MMA(0, 1, At, B1); PG8_BAR;
            PG8_LDA(At, 0, 1); PG8_STAGE(PG8_SA(0, 0), a2, voffA);
            PG8_BAR; PG8_WAIT_L(0); PG8_MMA(1, 0, At, B0); PG8_BAR; PG8_SCHED;
            PG8_STAGE(PG8_SB(0, 1), b2 + hstepB, voffB);
            PG8_WAIT_V(6); PG8_BAR; PG8_MMA(1, 1, At, B1); PG8_BAR;
            PG8_LDB(B0, 1, 0); PG8_SCHED; PG8_LDA(At, 1, 0); PG8_STAGE(PG8_SA(0, 1), a2 + hstepA, voffA);
            PG8_WAIT_L(8); PG8_BAR; PG8_WAIT_L(0); PG8_MMA(0, 0, At, B0); PG8_BAR; PG8_SCHED;
            PG8_LDB(B1, 1, 1); PG8_STAGE(PG8_SB(1, 0), b3, voffB);
            PG8_BAR; PG8_WAIT_L(0); PG8_MMA(0, 1, At, B1); PG8_BAR;
            PG8_LDA(At, 1, 1); PG8_STAGE(PG8_SA(1, 0), a3, voffA);
            PG8_BAR; PG8_WAIT_L(0); PG8_MMA(1, 0, At, B0); PG8_BAR; PG8_SCHED;
            PG8_STAGE(PG8_SB(1, 1), b3 + hstepB, voffB);
            PG8_WAIT_V(6); PG8_BAR; PG8_MMA(1, 1, At, B1); PG8_BAR;
            }
        }
        if constexpr (ALIGN_EPI) { if (wr == 0) PG8_BAR; }
        if constexpr (!Epi::AFTER_DRAIN) { E(acc, cur, wr, wc, fr, fq); S.done(cur); }
        if (!has_next) break;
#pragma unroll
        for (int a = 0; a < 2; ++a)
#pragma unroll
            for (int b = 0; b < 2; ++b)
#pragma unroll
                for (int m = 0; m < 4; ++m)
#pragma unroll
                    for (int n = 0; n < 2; ++n) acc[a][b][m][n] = (f32x4){0.f, 0.f, 0.f, 0.f};
        cur = nxt; cA = nA; cB = nB; ++ui;
        if constexpr (ALIGN_EPI) { if (wr == 1) PG8_BAR; }
    }
    PG8_WAIT_V(0);
    if constexpr (!ALIGN_EPI) { if (wr == 0) PG8_BAR; }
    PG8_BAR;
    if constexpr (Epi::AFTER_DRAIN) { E.fused(acc, cur, wr, wc, fr, fq, lds, wid, lane); S.done(cur); }
#undef PG8_SA
#undef PG8_SB
#undef PG8_STAGE
#undef PG8_LDA
#undef PG8_LDB
#undef PG8_MMA
#undef PG8_WAIT_V
#undef PG8_WAIT_L
#undef PG8_BAR
#undef PG8_SCHED
}
}

namespace pg8 {
template <int ACT> struct EpiScaleBf16 {
    static constexpr bool PERM = true, AFTER_DRAIN = false;
    bf16_t* O; int ldc; const float* ssp; bf16_t* halo; float* small;
    __device__ __forceinline__ void operator()(const f32x4 (&acc)[2][2][4][2], const Unit& u, int wr, int wc, int fr, int fq) const {
        const int row0 = u.pm * BM + wr * 64 + fr, col0 = u.pn * BM + wc * 32 + 8 * fq;
        float rsv[8];
#pragma unroll
        for (int k = 0; k < 8; ++k) { const f32x4 p = *(const f32x4*)(ssp + (size_t)(row0 + (k >> 2) * HALF + (k & 3) * 16) * 16 + 4 * fq); rsv[k] = (p[0] + p[1]) + (p[2] + p[3]); }
#pragma unroll
        for (int k = 0; k < 8; ++k) { float t = rsv[k]; t += __shfl_xor(t, 16); t += __shfl_xor(t, 32); rsv[k] = rsqrt_f(t * (1.f / DM) + NORM_EPS); }
#pragma unroll
        for (int ai = 0; ai < 2; ++ai)
#pragma unroll
            for (int m = 0; m < 4; ++m) { const int row = row0 + ai * HALF + m * 16; const float rs = rsv[ai * 4 + m]; bf16_t* rowp = O + (size_t)row * ldc + col0;
#pragma unroll
                for (int bj = 0; bj < 2; ++bj) { f32x4 v0 = acc[ai][bj][m][0] * rs, v1 = acc[ai][bj][m][1] * rs;
                    if (ACT == 0 && u.pn == NP / BM) {
                        if (bj == 0 && wc == 0 && fq < 2) { *(f32x4*)(small + (size_t)row * 16 + 8 * fq) = v0; *(f32x4*)(small + (size_t)row * 16 + 8 * fq + 4) = v1; }
                        continue; }
                    if (ACT == 1) {
#pragma unroll
                        for (int i = 0; i < 4; ++i) { const float a = fmaxf(v0[i], 0.f), b = fmaxf(v1[i], 0.f); v0[i] = a * a; v1[i] = b * b; } }
                    u32x4 w; w.x = cvt_pk_bf16(v0[0], v0[1]); w.y = cvt_pk_bf16(v0[2], v0[3]); w.z = cvt_pk_bf16(v1[0], v1[1]); w.w = cvt_pk_bf16(v1[2], v1[3]);
                    *(u32x4*)(rowp + bj * HALF) = w;
                    if (ACT == 0 && m == 3) { if (halo && fr >= 13 && (u.pn == 8 || u.pn == 9 || u.pn == 18 || u.pn == 19)) { const int col = col0 + bj * HALF;
                        const int ch = (u.pn < 10) ? (512 + col - C_SB) : (col - C_SX);
                        *(u32x4*)(halo + ((size_t)(row >> 6) * 3 + (fr - 13)) * 1024 + ch) = w; } } } }
    }
};
struct EpiRes {
    static constexpr bool PERM = false, AFTER_DRAIN = false;
    const float* base; float* outx; bf16_t* xb; float* ss_out;
    __device__ __forceinline__ void operator()(const f32x4 (&acc)[2][2][4][2], const Unit& u, int wr, int wc, int fr, int fq) const {
        typedef unsigned u32x2v __attribute__((ext_vector_type(2)));
        const int row0 = u.pm * BM + wr * 64 + fr, col0 = u.pn * BM + wc * 32 + 4 * fq;
#pragma unroll
        for (int ai = 0; ai < 2; ++ai)
#pragma unroll
            for (int m = 0; m < 4; ++m) { const int row = row0 + ai * HALF + m * 16; const size_t off = (size_t)row * DM + col0; float sq = 0.f;
#pragma unroll
                for (int bj = 0; bj < 2; ++bj)
#pragma unroll
                    for (int n = 0; n < 2; ++n) { const size_t o = off + bj * HALF + n * 16; const f32x4 xn = *(const f32x4*)(base + o) + acc[ai][bj][m][n];
                        *(f32x4*)(outx + o) = xn; u32x2v w; w.x = cvt_pk_bf16(xn[0], xn[1]); w.y = cvt_pk_bf16(xn[2], xn[3]); *(u32x2v*)(xb + o) = w;
                        sq += (xn[0] * xn[0] + xn[1] * xn[1]) + (xn[2] * xn[2] + xn[3] * xn[3]); }
                sq += __shfl_xor(sq, 16); sq += __shfl_xor(sq, 32);
                if (fq == 0) ss_out[(size_t)row * 16 + u.pn * 4 + wc] = sq; }
    }
};
}

#define GAS __attribute__((address_space(1)))
#define LAS __attribute__((address_space(3)))
constexpr int NWAVES = 8;
constexpr int RING_OFF = 0, RING_BYTES = 131072;
constexpr int LDSCTL_OFF = 161792, MISC_OFF = LDSCTL_OFF + 320;
constexpr int LDS_BYTES = 163840;
constexpr int CW_BAR = 4096;
constexpr size_t CTL_ZERO_BYTES = 64 * 1024;
typedef unsigned v4u __attribute__((ext_vector_type(4)));
#define LDS_WAIT() asm volatile("s_waitcnt lgkmcnt(0)" ::: "memory")
#define XB_TMO      128
#define XB_XCNT(j)  (256  + 64 * (j))
#define XB_XSUB(j)  (1280 + 64 * (j))
#define XB_XGEN(j)  (2304 + 64 * (j))
#define XB_TOP      3328
#define XB_TOPGEN   3392
#define XCD_BAR_WORDS 3456
#define XB_SPIN_CAP (1u << 18)

__device__ __forceinline__ unsigned xb_ld(unsigned* p)              { return __hip_atomic_load(p, __ATOMIC_RELAXED, __HIP_MEMORY_SCOPE_AGENT); }
__device__ __forceinline__ unsigned xb_add(unsigned* p, unsigned v) { return __hip_atomic_fetch_add(p, v, __ATOMIC_RELAXED, __HIP_MEMORY_SCOPE_AGENT); }
__device__ __forceinline__ unsigned xb_xcc_id() { return (unsigned)__builtin_amdgcn_s_getreg((3 << 11) | 20) & 0xFu; }
#define XB_SPIN(cond, bar) do { unsigned _sp = 0; while (cond) { __builtin_amdgcn_s_sleep(1); \
    if ((++_sp & 255u) == 0u) { if (xb_ld(&(bar)[XB_TMO])) break; if (_sp > XB_SPIN_CAP) { atomicAdd(&(bar)[XB_TMO], 1u); break; } } } } while (0)

struct XcdBarrier {
    unsigned* bar; unsigned x;
    volatile LAS unsigned* st;
};

__device__ __forceinline__ XcdBarrier xcd_barrier_post(unsigned* bar, volatile LAS unsigned* st) {
    XcdBarrier b; b.bar = bar; b.x = xb_xcc_id(); b.st = st;
    if (threadIdx.x == 0) (void)xb_add(&bar[XB_XCNT(b.x)], 1u);
    return b;
}
__device__ __forceinline__ void xcd_barrier_complete(unsigned* bar, unsigned x, unsigned& nloc, unsigned& nx) {
    const unsigned G = gridDim.x * gridDim.y * gridDim.z;
    unsigned sum, cnt, mine, sp = 0u;
    for (;;) {
        sum = 0u; cnt = 0u; mine = 0u;
#pragma unroll
        for (unsigned j = 0; j < 16; ++j) { const unsigned c = xb_ld(&bar[XB_XCNT(j)]); sum += c; cnt += (c > 0u) ? 1u : 0u; mine = (j == x) ? c : mine; }
        if (sum == G) break;
        __builtin_amdgcn_s_sleep(1);
        if ((++sp & 255u) == 0u) { if (xb_ld(&bar[XB_TMO])) break; if (sp > XB_SPIN_CAP) { atomicAdd(&bar[XB_TMO], 1u); break; } }
    }
    nloc = mine > 0u ? mine : 1u; nx = cnt > 0u ? cnt : 1u;
}

__device__ __forceinline__ void xcd_barrier(const XcdBarrier& b) {
    asm volatile("s_waitcnt vmcnt(0)" ::: "memory");
    __syncthreads();
    if (threadIdx.x == 0) {
        unsigned* bar = b.bar;
        __builtin_amdgcn_s_waitcnt(0);
        unsigned nloc = b.st[0], nx = b.st[1];
        if (nloc == 0u) { xcd_barrier_complete(bar, b.x, nloc, nx); b.st[0] = nloc; b.st[1] = nx; }
        const unsigned old = xb_add(&bar[XB_XSUB(b.x)], 1u);
        const unsigned gen = old / nloc;
        if (old + 1u == (gen + 1u) * nloc) {
            __builtin_amdgcn_fence(__ATOMIC_RELEASE, "agent");
            asm volatile("s_waitcnt vmcnt(0)" ::: "memory");
            const unsigned og = xb_add(&bar[XB_TOP], 1u);
            const unsigned tg = og / nx;
            if (og + 1u == (tg + 1u) * nx) xb_add(&bar[XB_TOPGEN], 1u);
            else XB_SPIN(xb_ld(&bar[XB_TOPGEN]) == tg, bar);
            __builtin_amdgcn_fence(__ATOMIC_ACQUIRE, "agent");
            xb_add(&bar[XB_XGEN(b.x)], 1u);
            asm volatile("s_waitcnt vmcnt(0)" ::: "memory");
        } else {
            XB_SPIN(xb_ld(&bar[XB_XGEN(b.x)]) == gen, bar);
            __builtin_amdgcn_fence(__ATOMIC_ACQUIRE, "agent");
            asm volatile("s_waitcnt vmcnt(0)" ::: "memory");
        }
    }
    __syncthreads();
}

template <bool MAPIN> __device__ __forceinline__ void transpose_item(const float* W, int K, int Nsrc, int Ndst, int Nvalid, const float* kscale, bf16_t* WT, LAS float* scr, int item, int lane) {
    const int nblk = (Ndst + 31) / 32, kb = item / nblk, nb = item % nblk, k0 = 64 * kb, n0 = 32 * nb;
    const int nn = n0 + (lane & 31); const bool ok = nn < Nvalid; const int sc = MAPIN ? c_new2orig(ok ? nn : 0) : nn;
#pragma unroll 8
    for (int i = 0; i < 32; ++i) { const int kk = 2 * i + (lane >> 5); float v = ok ? __builtin_nontemporal_load(&W[(size_t)(k0 + kk) * Nsrc + sc]) : 0.f; if (kscale) v *= kscale[k0 + kk]; scr[kk * 33 + (lane & 31)] = v; }
    LDS_WAIT(); asm volatile("" ::: "memory");
    const int c = lane & 7;
#pragma unroll
    for (int j = 0; j < 4; ++j) { const int n = (lane >> 3) + 8 * j; const LAS float* s = scr + (8 * c) * 33 + n;
        v4u o; o.x = pk2(s[0 * 33], s[1 * 33]); o.y = pk2(s[2 * 33], s[3 * 33]); o.z = pk2(s[4 * 33], s[5 * 33]); o.w = pk2(s[6 * 33], s[7 * 33]);
        if (n0 + n < Ndst) *(v4u*)(WT + (size_t)(n0 + n) * K + k0 + 8 * c) = o; }
    LDS_WAIT(); asm volatile("" ::: "memory");
}
__device__ __forceinline__ void convert_layer_weights(const Params& P, int layer, LAS float* scr, int gw, int NGW, int lane, int which = 0) {
    unsigned char* wset = P.ws + WS_W + (size_t)(layer & 1) * WSET;
    constexpr int I_IN = (DM / 64) * (NPX / 32), I_OUT = (MIXW / 64) * (DM / 32), I_UP = (DM / 64) * (DFF / 32), I_DN = (DFF / 64) * (DM / 32);
    const int lo = (which == 2) ? I_IN : 0, hi = (which == 1) ? I_IN : I_IN + I_OUT + I_UP + I_DN;
    for (int it = lo + gw; it < hi; it += NGW) {
        int r = it;
        if (r < I_IN) { transpose_item<true>(P.w_in + (size_t)layer * DM * DIN, DM, DIN, NPX, DIN, P.mix_norm_w + layer * DM, (bf16_t*)(wset + W_IN), scr, r, lane); continue; } r -= I_IN;
        if (r < I_OUT) { transpose_item<false>(P.w_out + (size_t)layer * MIXW * DM, MIXW, DM, DM, DM, nullptr, (bf16_t*)(wset + W_OUT), scr, r, lane); continue; } r -= I_OUT;
        if (r < I_UP) { transpose_item<false>(P.w_up + (size_t)layer * DM * DFF, DM, DFF, DFF, DFF, P.mlp_norm_w + layer * DM, (bf16_t*)(wset + W_UP), scr, r, lane); continue; } r -= I_UP;
        transpose_item<false>(P.w_down + (size_t)layer * DFF * DM, DFF, DM, DM, DM, nullptr, (bf16_t*)(wset + W_DOWN), scr, r, lane);
    }
}
typedef short bf16x8 __attribute__((ext_vector_type(8)));
typedef float f32x16 __attribute__((ext_vector_type(16)));
typedef unsigned short u16x8 __attribute__((ext_vector_type(8)));
typedef unsigned v2u __attribute__((ext_vector_type(2)));
typedef float f32x4_t __attribute__((ext_vector_type(4)));
__device__ __forceinline__ v4u mk4(unsigned a, unsigned b, unsigned c, unsigned d) { v4u r; r.x = a; r.y = b; r.z = c; r.w = d; return r; }
#define MFMA32(a, b, c) __builtin_amdgcn_mfma_f32_32x32x16_bf16((a), (b), (c), 0, 0, 0)
__device__ __forceinline__ int crow(int i, int h) { return (i & 3) + 8 * (i >> 2) + 4 * h; }
template <int KS> __device__ __forceinline__ void mma_nt(f32x16& acc, const LAS unsigned char* A, int lda, const LAS unsigned char* Bt, int ldb, int r, int h) {
#pragma unroll
    for (int ks = 0; ks < KS; ++ks) {
        const bf16x8 a = *(const LAS bf16x8*)(A + r * lda + ks * 32 + h * 16);
        const bf16x8 b = *(const LAS bf16x8*)(Bt + r * ldb + ks * 32 + h * 16);
        acc = MFMA32(a, b, acc);
    }
}
__device__ __forceinline__ void store_acc_T(const f32x16& v, LAS unsigned char* dst, int ldt, int r, int h) {
#pragma unroll
    for (int g = 0; g < 4; ++g) { v2u w; w.x = pk2(v[4 * g], v[4 * g + 1]); w.y = pk2(v[4 * g + 2], v[4 * g + 3]); *(LAS v2u*)(dst + r * ldt + (8 * g + 4 * h) * 2) = w; }
}
__device__ __forceinline__ float bfsel(const v4u& v, int c) { const unsigned u = v[c >> 1]; return __uint_as_float((c & 1) ? (u & 0xffff0000u) : (u << 16)); }
__device__ __forceinline__ f32x16 zero16() { f32x16 z;
#pragma unroll
    for (int i = 0; i < 16; ++i) z[i] = 0.f; return z; }

__device__ __forceinline__ bf16x8 pack_acc(const f32x16& x, int s) {
    v4u p; p.x = pk2(x[8 * s], x[8 * s + 1]); p.y = pk2(x[8 * s + 2], x[8 * s + 3]); p.z = pk2(x[8 * s + 4], x[8 * s + 5]); p.w = pk2(x[8 * s + 6], x[8 * s + 7]);
    return __builtin_bit_cast(bf16x8, p);
}
__device__ __forceinline__ void store_rows_bf16(bf16_t* base_row4h, const int pitch, const f32x16& y0, const f32x16& y1) {
    bf16_t* p = base_row4h;
#pragma unroll
    for (int cb = 0; cb < 2; ++cb)
#pragma unroll
        for (int g = 0; g < 4; ++g) { asm volatile("" : "+v"(p));
#pragma unroll
            for (int q = 0; q < 4; ++q) { p[(size_t)q * pitch] = f2bf(cb == 0 ? y0[4 * g + q] : y1[4 * g + q]); }
            p += (size_t)8 * pitch; }
}
typedef short s16x4 __attribute__((ext_vector_type(4)));
__device__ __forceinline__ bf16x8 tr_frag(const LAS unsigned char* p, const int stride) {
    const s16x4 a = __builtin_amdgcn_ds_read_tr16_b64_v4i16((LAS s16x4*)p), b = __builtin_amdgcn_ds_read_tr16_b64_v4i16((LAS s16x4*)(p + 4 * stride));
    return __builtin_shufflevector(a, b, 0, 1, 2, 3, 4, 5, 6, 7);
}
__device__ __forceinline__ void store_cols_bf16(bf16_t* base, const size_t pitch, const f32x16& y0, const f32x16& y1) {
    typedef __attribute__((address_space(1))) v2u* gp_t;
#pragma unroll
    for (int lb = 0; lb < 2; ++lb)
#pragma unroll
        for (int g = 0; g < 4; ++g) { v2u o; o.x = lb == 0 ? pk2(y0[4 * g], y0[4 * g + 1]) : pk2(y1[4 * g], y1[4 * g + 1]); o.y = lb == 0 ? pk2(y0[4 * g + 2], y0[4 * g + 3]) : pk2(y1[4 * g + 2], y1[4 * g + 3]);
            *(gp_t)(base + (size_t)lb * 32 * pitch + 8 * g) = o; }
}
#define WG_BAR() do { asm volatile("s_waitcnt lgkmcnt(0)" ::: "memory"); __builtin_amdgcn_s_barrier(); asm volatile("" ::: "memory"); } while (0)
__device__ __forceinline__ void ret_prep_rot(const Params& P, int gt, int ng) {
    bf16_t* proj = (bf16_t*)(P.ws + WS_PROJ); const float* cs = (const float*)(P.ws + WS_COS); const float* sn = (const float*)(P.ws + WS_SIN);
    for (int idx = gt; idx < T * 32; idx += ng) { const int row = idx >> 5, hd = (idx >> 3) & 3, i0 = (idx & 7) * 8;
        bf16_t* pr = proj + (size_t)row * NP + hd * 128 + i0;
        const v4u q1 = *(const v4u*)(pr + C_RQ), q2 = *(const v4u*)(pr + C_RQ + 64), k1 = *(const v4u*)(pr + C_RK), k2 = *(const v4u*)(pr + C_RK + 64);
        const f32x4_t c0 = *(const f32x4_t*)(cs + (size_t)row * 64 + i0), c1 = *(const f32x4_t*)(cs + (size_t)row * 64 + i0 + 4), s0 = *(const f32x4_t*)(sn + (size_t)row * 64 + i0), s1 = *(const f32x4_t*)(sn + (size_t)row * 64 + i0 + 4);
        const float cc[8] = {c0[0], c0[1], c0[2], c0[3], c1[0], c1[1], c1[2], c1[3]}, ss_[8] = {s0[0], s0[1], s0[2], s0[3], s1[0], s1[1], s1[2], s1[3]};
        const float lg = log2f(1.f - exp2f(-5.f - (float)hd)), zeta = __builtin_amdgcn_exp2f((float)(63 - (row & 63)) * lg);
        float qa[8], qb[8], ka[8], kb[8];
#pragma unroll
        for (int j = 0; j < 8; ++j) { const float a1 = bfsel(q1, j), a2 = bfsel(q2, j), b1 = bfsel(k1, j), b2 = bfsel(k2, j);
            qa[j] = (a1 * cc[j] - a2 * ss_[j]) * 0.08838834764831845f; qb[j] = (a2 * cc[j] + a1 * ss_[j]) * 0.08838834764831845f; ka[j] = (b1 * cc[j] - b2 * ss_[j]) * zeta; kb[j] = (b2 * cc[j] + b1 * ss_[j]) * zeta; }
        *(v4u*)(pr + C_RQ) = mk4(pk2(qa[0], qa[1]), pk2(qa[2], qa[3]), pk2(qa[4], qa[5]), pk2(qa[6], qa[7]));
        *(v4u*)(pr + C_RQ + 64) = mk4(pk2(qb[0], qb[1]), pk2(qb[2], qb[3]), pk2(qb[4], qb[5]), pk2(qb[6], qb[7]));
        *(v4u*)(pr + C_RK) = mk4(pk2(ka[0], ka[1]), pk2(ka[2], ka[3]), pk2(ka[4], ka[5]), pk2(ka[6], ka[7]));
        *(v4u*)(pr + C_RK + 64) = mk4(pk2(kb[0], kb[1]), pk2(kb[2], kb[3]), pk2(kb[4], kb[5]), pk2(kb[6], kb[7])); }
}
__device__ __forceinline__ void ret_prep_vt(const Params& P, int task, int tid) {
    bf16_t* proj = (bf16_t*)(P.ws + WS_PROJ);
    const int bh = task >> 6, n = task & 63, b = bh >> 2, hd = bh & 3, e = tid & 127, tg = tid >> 7;
    bf16_t* base = proj + ((size_t)b * SEQ + n * 64) * NP + C_RV + hd * 128;
    unsigned short v[16];
#pragma unroll
    for (int j = 0; j < 16; ++j) v[j] = base[(size_t)(16 * tg + j) * NP + e];
    const v4u o0 = mk4(v[0] | ((unsigned)v[1] << 16), v[2] | ((unsigned)v[3] << 16), v[4] | ((unsigned)v[5] << 16), v[6] | ((unsigned)v[7] << 16));
    const v4u o1 = mk4(v[8] | ((unsigned)v[9] << 16), v[10] | ((unsigned)v[11] << 16), v[12] | ((unsigned)v[13] << 16), v[14] | ((unsigned)v[15] << 16));
    __syncthreads();
    bf16_t* dst = base + (size_t)(e >> 1) * NP + (e & 1) * 64 + 16 * tg;
    *(v4u*)dst = o0; *(v4u*)(dst + 8) = o1;
}
constexpr int NSR = 2, NSS = 2, NSG = 1, RSPLIT = 36, SSPLIT = 36;
constexpr int WG_RET = 16 * NSR, WG_GDN = 16 * NSG, WG_SSD = 32 * NSS, WG_SEQ = WG_RET + WG_GDN + WG_SSD;
__device__ __forceinline__ int rseg_lo(int s) { return NSR == 1 ? (s == 0 ? 0 : 64) : NSR == 2 ? (s == 0 ? 0 : (s == 1 ? RSPLIT : 64)) : (s == 0 ? 0 : (s == 1 ? 32 : (s == 2 ? 52 : 64))); }
__device__ __forceinline__ int gseg_lo(int s) { return NSG == 1 ? (s == 0 ? 0 : 64) : (s == 0 ? 0 : (s == 1 ? 46 : 64)); }
__device__ __forceinline__ int sseg_lo(int s) { return NSS == 1 ? (s == 0 ? 0 : 64) : NSS == 2 ? (s == 0 ? 0 : (s == 1 ? SSPLIT : 64)) : (s == 0 ? 0 : (s == 1 ? 32 : (s == 2 ? 52 : 64))); }
constexpr int RS_Q = 0, RS_P = 17408, RS_V = 26624, RS_K = 45056, RS_BUF = 62464, RS_END = 2 * RS_BUF;
__device__ __forceinline__ void ret_seq(const Params& P, int layer, int prob, LAS unsigned char* L, int tid_in, bool dry = false) {
    bf16_t* proj = (bf16_t*)(P.ws + WS_PROJ);
    const int seg = prob % NSR, b = (prob / NSR) >> 2, hd = (prob / NSR) & 3, w = __builtin_amdgcn_readfirstlane(tid_in >> 6);
    const int n_full = rseg_lo(seg), n_end = rseg_lo(seg + 1);
    const float lg = log2f(1.f - exp2f(-5.f - (float)hd));
    const size_t rowb = (size_t)b * SEQ;
    if (w >= 4) {
        const int ht = tid_in - 256, last = n_end - 1;
        v4u PFA[12], PFB[12];
#define RET_LD(PF, chunk) do { const int c_ = min((chunk), last), cq_ = max(c_, n_full); const bf16_t* rk_ = proj + (rowb + (size_t)c_ * 64) * NP + hd * 128; const bf16_t* rq_ = proj + (rowb + (size_t)cq_ * 64) * NP + hd * 128; \
            _Pragma("unroll") for (int q = 0; q < 12; ++q) { const int vv = ht + 256 * (q & 3); const size_t o_ = (size_t)(vv >> 4) * NP + (vv & 15) * 8; \
                PF[q] = *(const v4u*)((q < 4) ? rq_ + C_RQ + o_ : ((q < 8) ? rk_ + C_RK + o_ : rk_ + C_RV + o_)); } } while (0)
#define RET_HBODY(n_, PF) do { const int n = (n_); int tid = tid_in; asm volatile("" : "+v"(tid)); const int lane = tid & 63, r = lane & 31, h = lane >> 5; \
            LAS unsigned char* Tn = L + ((n + 1) & 1) * RS_BUF; const bool fulln = (n + 1 >= n_full);     \
            _Pragma("unroll") for (int q = 0; q < 12; ++q) { const int vv = (tid - 256) + 256 * (q & 3), row = vv >> 4, c0 = (vv & 15) * 8; \
                *(LAS v4u*)((q < 8) ? Tn + ((q < 4) ? RS_Q : RS_K) + row * 272 + c0 * 2 : Tn + RS_V + (2 * row + (c0 >> 6)) * 144 + (c0 & 63) * 2) = PF[q]; }     \
            if (n + 1 >= n_full) WG_BAR();     \
            if (n + 1 < n_end && fulln && w < 7) {     \
                const int t = w - 4, ib = (t + 1) >> 1, jb = t >> 1; f32x16 sacc = zero16(); \
                mma_nt<8>(sacc, Tn + RS_Q + ib * 32 * 272, 272, Tn + RS_K + jb * 32 * 272, 272, r, h); \
                const int jj = jb * 32 + r; \
                _Pragma("unroll") for (int i = 0; i < 16; ++i) { const int ii = ib * 32 + crow(i, h); \
                    *(LAS bf16_t*)(Tn + RS_P + ii * 144 + jj * 2) = f2bf((ii >= jj) ? sacc[i] * __builtin_amdgcn_exp2f((float)(ii - 63) * lg) : 0.f); } } \
            RET_LD(PF, n + 3);     \
            WG_BAR();     } while (0)
        RET_LD(PFA, 0); RET_LD(PFB, 1);
        RET_HBODY(-1, PFA);
#pragma unroll 1
        for (int m = 0; m < n_end; m += 2) { RET_HBODY(m, PFB); RET_HBODY(m + 1, PFA); }
#undef RET_LD
#undef RET_HBODY
        return;
    }
    const int vs = w; const float cdec = exp2f(64.f * lg);
    f32x16 S[4];
#pragma unroll
    for (int k = 0; k < 4; ++k) S[k] = zero16();
#pragma unroll 1
    for (int n = -1; n < n_end; ++n) {
        int tid = tid_in; asm volatile("" : "+v"(tid));
        const int lane = tid & 63, r = lane & 31, h = lane >> 5;
        const LAS unsigned char* Tt = L + (n & 1) * RS_BUF; const bool full = (n >= n_full);
#define RET_STATE() do { const LAS unsigned char* kp = Tt + RS_K + (8 * h + ((lane & 15) >> 2)) * 272 + (16 * ((lane >> 4) & 1) + 4 * (lane & 3)) * 2; \
            _Pragma("unroll") for (int kb = 0; kb < 4; ++kb) S[kb] = S[kb] * cdec; \
            _Pragma("unroll") for (int ks = 0; ks < 4; ++ks) { const bf16x8 vb = *(const LAS bf16x8*)(Tt + RS_V + (vs * 32 + r) * 144 + (ks * 16 + 8 * h) * 2); \
                _Pragma("unroll") for (int kb = 0; kb < 4; ++kb) S[kb] = MFMA32(tr_frag(kp + ks * 16 * 272 + kb * 64, 272), vb, S[kb]); } } while (0)
        if (n >= 0 && full) {
            f32x16 y[2];
            v4u qf[16];
#pragma unroll
            for (int i = 0; i < 16; ++i) { const LAS unsigned char* ap = Tt + RS_Q + ((i & 1) * 32 + r) * 272 + ((i >> 1) * 16 + 4 * h) * 2;
                const v2u a0 = *(const LAS v2u*)ap, a1 = *(const LAS v2u*)(ap + 16); qf[i].x = a0.x; qf[i].y = a0.y; qf[i].z = a1.x; qf[i].w = a1.y; }
            __builtin_amdgcn_sched_barrier(0);
#pragma unroll
            for (int kb = 0; kb < 4; ++kb)
#pragma unroll
                for (int s = 0; s < 2; ++s) { const bf16x8 sa = pack_acc(S[kb], s);
#pragma unroll
                    for (int lb = 0; lb < 2; ++lb) y[lb] = (kb == 0 && s == 0) ? MFMA32(sa, __builtin_bit_cast(bf16x8, qf[lb]), zero16()) : MFMA32(sa, __builtin_bit_cast(bf16x8, qf[(kb * 2 + s) * 2 + lb]), y[lb]); }
#pragma unroll
            for (int lb = 0; lb < 2; ++lb) y[lb] = y[lb] * __builtin_amdgcn_exp2f((float)(lb * 32 + r + 1) * lg);
            WG_BAR();
#pragma unroll
            for (int lb = 0; lb < 2; ++lb)
#pragma unroll
                for (int ks = 0; ks < 4; ++ks) { if (ks >= 2 * lb + 2) continue;
                    y[lb] = MFMA32(*(const LAS bf16x8*)(Tt + RS_V + (vs * 32 + r) * 144 + (ks * 16 + 8 * h) * 2), *(const LAS bf16x8*)(Tt + RS_P + (lb * 32 + r) * 144 + (ks * 16 + 8 * h) * 2), y[lb]); }
            RET_STATE();
            if (!dry) store_cols_bf16(proj + (rowb + (size_t)n * 64 + r) * NP + C_RQ + hd * 128 + vs * 32 + 4 * h, NP, y[0], y[1]);
        } else {
            if (n + 1 >= n_full) WG_BAR();
            if (n >= 0) RET_STATE();
        }
#undef RET_STATE
        WG_BAR();
    }
}
__device__ __forceinline__ void ret_norm(const Params& P, int layer, int gt, int ng) {
    bf16_t* proj = (bf16_t*)(P.ws + WS_PROJ);
    for (int it = gt; it < T * 4 * 16; it += ng) { const int item = it >> 4, cg = it & 15, row = item >> 2, hd = item & 3;
        bf16_t* yp = proj + (size_t)row * NP + C_RV + hd * 128 + cg * 8;
        const u16x8 yv = *(const u16x8*)yp; const u16x8 zv = *(const u16x8*)(proj + (size_t)row * NP + C_RG + hd * 128 + cg * 8);
        float v[8], sq = 0.f;
#pragma unroll
        for (int j = 0; j < 8; ++j) { v[j] = bf2f(yv[j]); sq += v[j] * v[j]; }
        sq += __shfl_xor(sq, 1); sq += __shfl_xor(sq, 2); sq += __shfl_xor(sq, 4); sq += __shfl_xor(sq, 8);
        const float rs = rsqrt_f(sq * (1.f / 128.f) + NORM_EPS); const float* nwp = P.ret_norm_w + layer * 512 + hd * 128 + cg * 8;
#pragma unroll
        for (int j = 0; j < 8; ++j) v[j] = v[j] * rs * nwp[j] * silu_f(bf2f(zv[j]));
        *(v4u*)yp = mk4(pk2(v[0], v[1]), pk2(v[2], v[3]), pk2(v[4], v[5]), pk2(v[6], v[7])); }
}

__device__ __forceinline__ void gdn_norm(const Params& P, int layer, int gt, int ng) {
    bf16_t* proj = (bf16_t*)(P.ws + WS_PROJ);
    for (int it = gt; it < T * 4 * 16; it += ng) { const int item = it >> 4, cg = it & 15, row = item >> 2, hd = item & 3;
        bf16_t* yp = proj + (size_t)row * NP + C_GV + hd * 128 + cg * 8;
        const u16x8 yv = *(const u16x8*)yp; const u16x8 zv = *(const u16x8*)(proj + (size_t)row * NP + C_GZ + hd * 128 + cg * 8);
        float v[8], sq = 0.f;
#pragma unroll
        for (int j = 0; j < 8; ++j) { v[j] = bf2f(yv[j]); sq += v[j] * v[j]; }
        sq += __shfl_xor(sq, 1); sq += __shfl_xor(sq, 2); sq += __shfl_xor(sq, 4); sq += __shfl_xor(sq, 8);
        const float rs = rsqrt_f(sq * (1.f / 128.f) + NORM_EPS); const float* nwp = P.gdn_norm_w + layer * 128 + cg * 8;
#pragma unroll
        for (int j = 0; j < 8; ++j) v[j] = v[j] * rs * nwp[j] * silu_f(bf2f(zv[j]));
        *(v4u*)yp = mk4(pk2(v[0], v[1]), pk2(v[2], v[3]), pk2(v[4], v[5]), pk2(v[6], v[7])); }
}
__device__ __forceinline__ void ssd_prep(const Params& P, int layer, int task, int tid) {
    bf16_t* proj = (bf16_t*)(P.ws + WS_PROJ); float* sm = (float*)(P.ws + WS_SMALL); float* acsb = (float*)(P.ws + WS_ACS); const bf16_t* halo = (const bf16_t*)(P.ws + WS_HALO);
    const int b = task >> 7, g = (task >> 6) & 1, n = task & 63, w = __builtin_amdgcn_readfirstlane(tid >> 6), cgp = tid & 63, lane = tid & 63;
    const size_t row0 = (size_t)b * SEQ + n * 64; const int chunk = b * 64 + n;
    const int colb = (cgp < 32) ? (C_SX + g * 256 + 8 * cgp) : ((cgp < 48) ? (C_SB + g * 128 + 8 * (cgp - 32)) : (C_SC + g * 128 + 8 * (cgp - 48)));
    const int chb = (cgp < 32) ? (g * 256 + 8 * cgp) : ((cgp < 48) ? (512 + g * 128 + 8 * (cgp - 32)) : (768 + g * 128 + 8 * (cgp - 48)));
    v4u R[11];
#pragma unroll
    for (int j = 0; j < 11; ++j) { const int tokrel = 8 * w + j - 3;
        if (tokrel >= 0) R[j] = *(const v4u*)(proj + (row0 + tokrel) * NP + colb);
        else if (n > 0) R[j] = *(const v4u*)(halo + ((size_t)(chunk - 1) * 3 + j) * 1024 + chb);
        else R[j] = mk4(0u, 0u, 0u, 0u); }
    const float* cw = P.ssd_conv_w + (size_t)layer * 4 * 1024 + chb; const float* cbp = P.ssd_conv_b + layer * 1024 + chb;
    v4u tokv[8];
#pragma unroll
    for (int j = 0; j < 8; ++j) tokv[j] = mk4(0u, 0u, 0u, 0u);
    v4u chv[8];
#pragma unroll
    for (int c = 0; c < 8; ++c) { const float w0 = cw[c], w1 = cw[1024 + c], w2 = cw[2048 + c], w3 = cw[3072 + c], bs = cbp[c]; float o[8];
#pragma unroll
        for (int j = 0; j < 8; ++j) { const float a = w0 * bfsel(R[j], c) + w1 * bfsel(R[j + 1], c) + w2 * bfsel(R[j + 2], c) + w3 * bfsel(R[j + 3], c) + bs;
            o[j] = a * __builtin_amdgcn_rcpf(1.f + __expf(-a)); }
        chv[c] = mk4(pk2(o[0], o[1]), pk2(o[2], o[3]), pk2(o[4], o[5]), pk2(o[6], o[7]));
#pragma unroll
        for (int j = 0; j < 8; ++j) { const unsigned hv = (chv[c][j >> 1] >> (16 * (j & 1))) & 0xffffu; tokv[j][c >> 1] |= hv << (16 * (c & 1)); } }
    float dtv = 0.f, acv = 0.f;
    if (w < 4) {
        const int hg = 4 * g + w; dtv = softplus_f(sm[(row0 + lane) * 16 + hg] + P.ssd_dt_bias[layer * 8 + hg]); acv = dtv * -__expf(P.ssd_a_log[layer * 8 + hg]);
#pragma unroll
        for (int o = 1; o < 64; o <<= 1) { const float t = __shfl_up(acv, o); if (lane >= o) acv += t; } }
    __syncthreads();
    if (cgp < 32) {
#pragma unroll
        for (int c = 0; c < 8; ++c) { const int p = 8 * cgp + c; *(v4u*)(proj + (row0 + (p & 63)) * NP + C_SX + g * 256 + (p >> 6) * 64 + 8 * w) = chv[c]; } }
    else {
#pragma unroll
        for (int j = 0; j < 8; ++j) *(v4u*)(proj + (row0 + 8 * w + j) * NP + colb) = tokv[j]; }
    if (w < 4) { sm[(row0 + lane) * 16 + 4 * g + w] = dtv; acsb[(row0 + lane) * 8 + 4 * g + w] = acv; }
}
constexpr int SQ_C = 0, SQ_W = 17408, SQ_X = 26624, SQ_B = 35840, SQ_A = 53248, SQ_BUF = 54528, SQ_END = 2 * SQ_BUF;
__device__ __forceinline__ void ssd_seq(const Params& P, int layer, int prob, LAS unsigned char* L, int tid_in, bool dry = false) {
    bf16_t* proj = (bf16_t*)(P.ws + WS_PROJ); const float* sm = (const float*)(P.ws + WS_SMALL); const float* acsb = (const float*)(P.ws + WS_ACS);
    const int seg = prob % NSS, b = (prob / NSS) >> 3, hg = (prob / NSS) & 7, g = hg >> 2, hh = hg & 3, w = __builtin_amdgcn_readfirstlane(tid_in >> 6);
    const int n_full = sseg_lo(seg), n_end = sseg_lo(seg + 1);
    const size_t rowb = (size_t)b * SEQ;
    if (w >= 2) {
        const int ht = tid_in - 128, last = n_end - 1; const float dsk = P.ssd_d[layer * 8 + hg];
        v4u PFA[7], PFB[7]; float paA, pdA, paB, pdB;
#define SSD_LD(PF, pa, pd, chunk) do { const int c_ = min((chunk), last), cq_ = max(c_, n_full); const size_t r0_ = rowb + (size_t)c_ * 64, rq_ = rowb + (size_t)cq_ * 64; \
            pa = acsb[(r0_ + (ht & 63)) * 8 + hg]; pd = sm[(r0_ + (ht & 63)) * 16 + hg]; \
            _Pragma("unroll") for (int q = 0; q < 7; ++q) { const int v = min(ht + 384 * q, 2559), vv = v & 1023; \
                const bf16_t* p_ = (v < 1024) ? proj + (rq_ + (vv >> 4)) * NP + C_SC + g * 128 + (vv & 15) * 8 : ((v < 2048) ? proj + (r0_ + (vv >> 4)) * NP + C_SB + g * 128 + (vv & 15) * 8 \
                                                                                                                          : proj + (r0_ + (vv >> 3)) * NP + C_SX + g * 256 + hh * 64 + (vv & 7) * 8); \
                PF[q] = *(const v4u*)p_; } } while (0)
#define SSD_HBODY(n_, PF, pa, pd) do { const int n = (n_); int tid = tid_in; asm volatile("" : "+v"(tid)); const int lane = tid & 63, r = lane & 31, h = lane >> 5; \
            LAS unsigned char* Tn = L + ((n + 1) & 1) * SQ_BUF;         \
            const bool fulln = (n + 1 >= n_full);                       \
            _Pragma("unroll") for (int q = 0; q < 7; ++q) { const int v = min((tid - 128) + 384 * q, 2559), vv = v & 1023; \
                *(LAS v4u*)((v < 2048) ? Tn + ((v < 1024) ? SQ_C : SQ_B) + (vv >> 4) * 272 + (vv & 15) * 16 : Tn + SQ_X + (vv >> 3) * 144 + (vv & 7) * 16) = PF[q]; } \
            if (w == 7) { const float a_end = __shfl(pa, 63);     \
                *(LAS float*)(Tn + SQ_A + lane * 4) = pa; *(LAS float*)(Tn + SQ_A + 256 + lane * 4) = pd; \
                *(LAS float*)(Tn + SQ_A + 512 + lane * 4) = __expf(pa); *(LAS float*)(Tn + SQ_A + 768 + lane * 4) = pd * __expf(a_end - pa); \
                if (lane == 63) *(LAS float*)(Tn + SQ_A + 1024) = __expf(pa); } \
            if (n + 1 >= n_full) WG_BAR();     \
            if (n + 1 < n_end && fulln && w < 5) {     \
                const int t = w - 2, ib = (t + 1) >> 1, jb = t >> 1; f32x16 sacc = zero16(); \
                mma_nt<8>(sacc, Tn + SQ_C + ib * 32 * 272, 272, Tn + SQ_B + jb * 32 * 272, 272, r, h); \
                const LAS float* acs = (const LAS float*)(Tn + SQ_A); const LAS float* dtv = acs + 64; \
                const int m = jb * 32 + r; const float am = acs[m], dm = dtv[m]; \
                _Pragma("unroll") for (int i = 0; i < 16; ++i) { const int l = ib * 32 + crow(i, h); float v = (m <= l) ? sacc[i] * __expf(acs[l] - am) * dm : 0.f; if (m == l) v += dsk; \
                    *(LAS bf16_t*)(Tn + SQ_W + l * 144 + m * 2) = f2bf(v); } } \
            SSD_LD(PF, pa, pd, n + 3);     \
            WG_BAR();     } while (0)
        SSD_LD(PFA, paA, pdA, 0); SSD_LD(PFB, paB, pdB, 1);
        SSD_HBODY(-1, PFA, paA, pdA);
#pragma unroll 1
        for (int m = 0; m < n_end; m += 2) { SSD_HBODY(m, PFB, paB, pdB); SSD_HBODY(m + 1, PFA, paA, pdA); }
#undef SSD_LD
#undef SSD_HBODY
        return;
    }
    const int pb = w;
    f32x16 st[4];
#pragma unroll
    for (int k = 0; k < 4; ++k) st[k] = zero16();
#pragma unroll 1
    for (int n = -1; n < n_end; ++n) {
        int tid = tid_in; asm volatile("" : "+v"(tid));
        const int lane = tid & 63, r = lane & 31, h = lane >> 5; const bool full = (n >= n_full);
        const LAS unsigned char* Tt = L + (n & 1) * SQ_BUF; const LAS float* acs = (const LAS float*)(Tt + SQ_A);
#define SSD_STATE() do { const float cd = acs[256]; \
            const LAS unsigned char* bp = Tt + SQ_B + (8 * h + ((lane & 15) >> 2)) * 272 + (16 * ((lane >> 4) & 1) + 4 * (lane & 3)) * 2; \
            _Pragma("unroll") for (int kb = 0; kb < 4; ++kb) st[kb] = st[kb] * cd; \
            _Pragma("unroll") for (int ks = 0; ks < 4; ++ks) { const int m0 = ks * 16 + 8 * h; \
                const u16x8 xr = *(const LAS u16x8*)(Tt + SQ_X + (pb * 32 + r) * 144 + m0 * 2); \
                const f32x4_t f0 = *(const LAS f32x4_t*)(acs + 192 + m0), f1 = *(const LAS f32x4_t*)(acs + 196 + m0); \
                const v4u xv = mk4(pk2(bf2f(xr[0]) * f0[0], bf2f(xr[1]) * f0[1]), pk2(bf2f(xr[2]) * f0[2], bf2f(xr[3]) * f0[3]), pk2(bf2f(xr[4]) * f1[0], bf2f(xr[5]) * f1[1]), pk2(bf2f(xr[6]) * f1[2], bf2f(xr[7]) * f1[3])); \
                _Pragma("unroll") for (int kb = 0; kb < 4; ++kb) st[kb] = MFMA32(tr_frag(bp + ks * 16 * 272 + kb * 64, 272), __builtin_bit_cast(bf16x8, xv), st[kb]); } } while (0)
        if (n >= 0 && full) {
            f32x16 y[2];
            v4u cf[16];
#pragma unroll
            for (int i = 0; i < 16; ++i) { const LAS unsigned char* ap = Tt + SQ_C + ((i & 1) * 32 + r) * 272 + ((i >> 1) * 16 + 4 * h) * 2;
                const v2u a0 = *(const LAS v2u*)ap, a1 = *(const LAS v2u*)(ap + 16); cf[i].x = a0.x; cf[i].y = a0.y; cf[i].z = a1.x; cf[i].w = a1.y; }
            const float e0 = acs[128 + r], e1 = acs[160 + r];
            __builtin_amdgcn_sched_barrier(0);
#pragma unroll
            for (int kb = 0; kb < 4; ++kb)
#pragma unroll
                for (int s = 0; s < 2; ++s) { const bf16x8 sa = pack_acc(st[kb], s);
#pragma unroll
                    for (int lb = 0; lb < 2; ++lb) y[lb] = (kb == 0 && s == 0) ? MFMA32(sa, __builtin_bit_cast(bf16x8, cf[lb]), zero16()) : MFMA32(sa, __builtin_bit_cast(bf16x8, cf[(kb * 2 + s) * 2 + lb]), y[lb]); }
            y[0] = y[0] * e0; y[1] = y[1] * e1;
            WG_BAR();
#pragma unroll
            for (int lb = 0; lb < 2; ++lb)
#pragma unroll
                for (int ks = 0; ks < 4; ++ks) { if (ks >= 2 * lb + 2) continue;
                    y[lb] = MFMA32(*(const LAS bf16x8*)(Tt + SQ_X + (pb * 32 + r) * 144 + (ks * 16 + 8 * h) * 2), *(const LAS bf16x8*)(Tt + SQ_W + (lb * 32 + r) * 144 + (ks * 16 + 8 * h) * 2), y[lb]); }
            SSD_STATE();
            if (!dry) store_cols_bf16((bf16_t*)(P.ws + WS_YS) + (rowb + (size_t)n * 64 + r) * 512 + g * 256 + hh * 64 + pb * 32 + 4 * h, 512, y[0], y[1]);
        } else {
            if (n + 1 >= n_full) WG_BAR();
            if (n >= 0) SSD_STATE();
        }
#undef SSD_STATE
        WG_BAR();
    }
}
__device__ __forceinline__ void ssd_norm(const Params& P, int layer, int gt, int ng) {
    bf16_t* proj = (bf16_t*)(P.ws + WS_PROJ);
    for (int it = gt; it < T * 2 * 32; it += ng) { const int item = it >> 5, cg = it & 31, row = item >> 1, g = item & 1;
        bf16_t* yp = proj + (size_t)row * NP + C_SX + g * 256 + cg * 8;
        const u16x8 yv = *(const u16x8*)yp; const u16x8 zv = *(const u16x8*)(proj + (size_t)row * NP + C_SZ + g * 256 + cg * 8);
        float v[8], sq = 0.f;
#pragma unroll
        for (int j = 0; j < 8; ++j) { v[j] = bf2f(yv[j]) * silu_f(bf2f(zv[j])); sq += v[j] * v[j]; }
        sq += __shfl_xor(sq, 1); sq += __shfl_xor(sq, 2); sq += __shfl_xor(sq, 4); sq += __shfl_xor(sq, 8); sq += __shfl_xor(sq, 16);
        const float rs = rsqrt_f(sq * (1.f / 256.f) + NORM_EPS); const float* nwp = P.ssd_norm_w + layer * 512 + g * 256 + cg * 8;
#pragma unroll
        for (int j = 0; j < 8; ++j) v[j] *= rs * nwp[j];
        *(v4u*)yp = mk4(pk2(v[0], v[1]), pk2(v[2], v[3]), pk2(v[4], v[5]), pk2(v[6], v[7])); }
}

constexpr int GREC = 62464, GR_W = 0, GR_QD = 17408, GR_KDT = 34816, GR_A = 53248;
constexpr int GP_Q = 0, GP_K = 17408, GP_KT = 34816, GP_VT = 53248, GP_L = 71680, GP_TU = 88064, GP_TW = 97280, GP_RQ = 106496, GP_RK = 106752, GP_GCS = 107008, GP_BETA = 107264, GP_END = 107520;
__device__ __forceinline__ int swz16(int k) { return (k & ~12) | ((k & 4) << 1) | ((k & 8) >> 1); }
__device__ __forceinline__ void gdn_prep(const Params& P, int layer, int task, LAS unsigned char* L, int tid_in) {
    int tid = tid_in; asm volatile("" : "+v"(tid));
    const bf16_t* proj = (const bf16_t*)(P.ws + WS_PROJ); const float* sm = (const float*)(P.ws + WS_SMALL);
    const int b = task >> 8, hd = (task >> 6) & 3, n = task & 63, t0 = n * 64, lane = tid & 63, w = __builtin_amdgcn_readfirstlane(tid >> 6), r = lane & 31, h = lane >> 5;
    const size_t row0 = (size_t)b * SEQ + t0;
    unsigned char* rec = P.ws + WS_GT + (size_t)task * GREC; unsigned* urec = (unsigned*)(P.ws + WS_XB) + (size_t)task * 4096;
    if (w < 6) {
        const int cgq = tid % 48, tg = tid / 48, type = cgq >> 4, d0 = (cgq & 15) * 8;
        const int col = (type == 0 ? C_GQ : (type == 1 ? C_GK : C_GV)) + hd * 128 + d0, ch = type * 512 + hd * 128 + d0;
        v4u R[11];
#pragma unroll
        for (int j = 0; j < 11; ++j) { const int tokrel = 8 * tg + j - 3; R[j] = (tokrel >= 0 || t0 > 0) ? *(const v4u*)(proj + ((size_t)row0 + tokrel) * NP + col) : mk4(0u, 0u, 0u, 0u); }
        const float* cw = P.gdn_conv_w + (size_t)layer * 4 * 1536 + ch;
        v4u tokv[8];
#pragma unroll
        for (int j = 0; j < 8; ++j) tokv[j] = mk4(0u, 0u, 0u, 0u);
#pragma unroll
        for (int c = 0; c < 8; ++c) { const float w0 = cw[c], w1 = cw[1536 + c], w2 = cw[3072 + c], w3 = cw[4608 + c]; float o[8];
#pragma unroll
            for (int j = 0; j < 8; ++j) o[j] = silu_f(w0 * bfsel(R[j], c) + w1 * bfsel(R[j + 1], c) + w2 * bfsel(R[j + 2], c) + w3 * bfsel(R[j + 3], c));
            const v4u chv = mk4(pk2(o[0], o[1]), pk2(o[2], o[3]), pk2(o[4], o[5]), pk2(o[6], o[7]));
            if (type == 1) *(LAS v4u*)(L + GP_KT + (d0 + c) * 144 + tg * 16) = chv;
            else if (type == 2) *(LAS v4u*)(L + GP_VT + (d0 + c) * 144 + tg * 16) = chv;
            if (type < 2) {
#pragma unroll
                for (int j = 0; j < 8; ++j) { const unsigned hv = (chv[j >> 1] >> (16 * (j & 1))) & 0xffffu; tokv[j][c >> 1] |= hv << (16 * (c & 1)); } } }
        if (type < 2) {
#pragma unroll
            for (int j = 0; j < 8; ++j) *(LAS v4u*)(L + (type == 0 ? GP_Q : GP_K) + (8 * tg + j) * 272 + d0 * 2) = tokv[j]; }
    } else if (w == 6) {
        const float beta = sigmoid_f(sm[(row0 + lane) * 16 + 8 + hd]);
        float c = -__expf(P.gdn_a_log[layer * 4 + hd]) * softplus_f(sm[(row0 + lane) * 16 + 12 + hd] + P.gdn_dt_bias[layer * 4 + hd]);
#pragma unroll
        for (int o = 1; o < 64; o <<= 1) { const float t = __shfl_up(c, o); if (lane >= o) c += t; }
        *(LAS float*)(L + GP_GCS + lane * 4) = c; *(LAS float*)(L + GP_BETA + lane * 4) = beta;
    }
    __syncthreads();
    { const int tok = tid >> 3, part = tid & 7; float sq = 0.f, sk = 0.f;
#pragma unroll
      for (int v = 0; v < 2; ++v) { const u16x8 a = *(const LAS u16x8*)(L + GP_Q + tok * 272 + part * 32 + v * 16), c = *(const LAS u16x8*)(L + GP_K + tok * 272 + part * 32 + v * 16);
#pragma unroll
          for (int j = 0; j < 8; ++j) { const float x = bf2f(a[j]), y = bf2f(c[j]); sq += x * x; sk += y * y; } }
      sq += __shfl_xor(sq, 1); sq += __shfl_xor(sq, 2); sq += __shfl_xor(sq, 4); sk += __shfl_xor(sk, 1); sk += __shfl_xor(sk, 2); sk += __shfl_xor(sk, 4);
      if (part == 0) { *(LAS float*)(L + GP_RQ + tok * 4) = (rsqrt_f(sq + L2_EPS)) * 0.08838834764831845f; *(LAS float*)(L + GP_RK + tok * 4) = rsqrt_f(sk + L2_EPS); } }
    __syncthreads();
    const LAS float* rq = (const LAS float*)(L + GP_RQ); const LAS float* rk = (const LAS float*)(L + GP_RK); const LAS float* gcs = (const LAS float*)(L + GP_GCS); const LAS float* bet = (const LAS float*)(L + GP_BETA);
    const float glast = gcs[63];
    if (w < 6) {
        const int t = (w < 3) ? w : w - 3, ib = (t + 1) >> 1, jb = t >> 1; f32x16 s = zero16();
        mma_nt<8>(s, L + ((w < 3) ? GP_K : GP_Q) + ib * 32 * 272, 272, L + GP_K + jb * 32 * 272, 272, r, h);
        const int jj = jb * 32 + r; const float rkj = rk[jj], gj = gcs[jj];
#pragma unroll
        for (int i = 0; i < 16; ++i) { const int ii = ib * 32 + crow(i, h); const float e = __expf(gcs[ii] - gj) * rkj * s[i];
            if (w < 3) *(LAS float*)(L + GP_L + (ii * 64 + jj) * 4) = (ii > jj) ? e * bet[ii] * rk[ii] : 0.f;
            else *(bf16_t*)(rec + GR_A + ii * 144 + (jb * 32 + swz16(r)) * 2) = f2bf((ii >= jj) ? e * rq[ii] : 0.f); }
    }
    __syncthreads();
    if (w == 0) {
        const int hb = lane >> 5, cc = lane & 31; float tc[32];
        const LAS float* Lb = (const LAS float*)(L + GP_L) + (hb * 32) * 64 + hb * 32;
#pragma unroll
        for (int i = 0; i < 32; ++i) { float a0 = (i == cc) ? 1.f : 0.f, a1 = 0.f;
            if ((i & 3) == 0 && i > 0) { int zz; asm volatile("v_mov_b32 %0, 0" : "=v"(zz) : "v"(tc[i - 1])); Lb += zz; }
#pragma unroll
            for (int j4 = 0; j4 < i; j4 += 4) { const f32x4_t lv = *(const LAS f32x4_t*)(Lb + i * 64 + j4);
                a0 -= lv[0] * tc[j4]; if (j4 + 1 < i) a1 -= lv[1] * tc[j4 + 1]; if (j4 + 2 < i) a0 -= lv[2] * tc[j4 + 2]; if (j4 + 3 < i) a1 -= lv[3] * tc[j4 + 3]; }
            tc[i] = a0 + a1; }
        const float bu = bet[lane], bw = bu * rk[lane] * __expf(gcs[lane]);
#pragma unroll
        for (int i = 0; i < 32; ++i) { const int row = hb * 32 + i;
            *(LAS bf16_t*)(L + GP_TU + row * 144 + lane * 2) = f2bf(tc[i] * bu); *(LAS bf16_t*)(L + GP_TW + row * 144 + lane * 2) = f2bf(tc[i] * bw);
            if (hb == 1) { *(LAS bf16_t*)(L + GP_TU + i * 144 + lane * 2) = 0; *(LAS bf16_t*)(L + GP_TW + i * 144 + lane * 2) = 0; } }
        LAS unsigned char* T11t = L + GP_END; LAS unsigned char* T22r = L + GP_END + 4096;
        if (hb == 0) {
#pragma unroll
            for (int k8 = 0; k8 < 4; ++k8) *(LAS v4u*)(T11t + cc * 80 + k8 * 16) = mk4(pk2(tc[8 * k8], tc[8 * k8 + 1]), pk2(tc[8 * k8 + 2], tc[8 * k8 + 3]), pk2(tc[8 * k8 + 4], tc[8 * k8 + 5]), pk2(tc[8 * k8 + 6], tc[8 * k8 + 7])); }
        else {
#pragma unroll
            for (int i = 0; i < 32; ++i) *(LAS bf16_t*)(T22r + i * 80 + cc * 2) = f2bf(tc[i]); }
        asm volatile("s_waitcnt lgkmcnt(0)" ::: "memory");
        f32x16 X = zero16();
#pragma unroll
        for (int ks = 0; ks < 2; ++ks) { const LAS float* lp = (const LAS float*)(L + GP_L) + (32 + r) * 64 + ks * 16 + 8 * h;
            const f32x4_t l0 = *(const LAS f32x4_t*)lp, l1 = *(const LAS f32x4_t*)(lp + 4);
            const v4u av = mk4(pk2(l0[0], l0[1]), pk2(l0[2], l0[3]), pk2(l1[0], l1[1]), pk2(l1[2], l1[3]));
            X = MFMA32(__builtin_bit_cast(bf16x8, av), *(const LAS bf16x8*)(T11t + r * 80 + ks * 32 + h * 16), X); }
        f32x16 T21 = zero16();
#pragma unroll
        for (int sx = 0; sx < 2; ++sx) { const LAS unsigned char* ap = T22r + r * 80 + (16 * sx + 4 * h) * 2;
            const v2u a0 = *(const LAS v2u*)ap, a1 = *(const LAS v2u*)(ap + 16); v4u av; av.x = a0.x; av.y = a0.y; av.z = a1.x; av.w = a1.y;
            T21 = MFMA32(__builtin_bit_cast(bf16x8, av), pack_acc(X, sx), T21); }
        { const float bu2 = bet[r], bw2 = bu2 * rk[r] * __expf(gcs[r]);
#pragma unroll
          for (int i = 0; i < 16; ++i) { const int row = 32 + crow(i, h);
              *(LAS bf16_t*)(L + GP_TU + row * 144 + r * 2) = f2bf(-T21[i] * bu2); *(LAS bf16_t*)(L + GP_TW + row * 144 + r * 2) = f2bf(-T21[i] * bw2); } }
    }
    else {
        const int lt = tid - 64;
#pragma unroll 1
        for (int it = lt; it < 512; it += 448) { const int c = it >> 3, grp = it & 7;
            const u16x8 a0 = *(const LAS u16x8*)(L + GP_Q + c * 272 + grp * 32), a1 = *(const LAS u16x8*)(L + GP_Q + c * 272 + grp * 32 + 16); const float sc = rq[c] * __expf(gcs[c]);
            const v4u o0 = mk4(pk2(bf2f(a0[0]) * sc, bf2f(a0[1]) * sc), pk2(bf2f(a0[2]) * sc, bf2f(a0[3]) * sc), pk2(bf2f(a1[0]) * sc, bf2f(a1[1]) * sc), pk2(bf2f(a1[2]) * sc, bf2f(a1[3]) * sc));
            const v4u o1 = mk4(pk2(bf2f(a0[4]) * sc, bf2f(a0[5]) * sc), pk2(bf2f(a0[6]) * sc, bf2f(a0[7]) * sc), pk2(bf2f(a1[4]) * sc, bf2f(a1[5]) * sc), pk2(bf2f(a1[6]) * sc, bf2f(a1[7]) * sc));
            *(v4u*)(rec + GR_QD + c * 272 + grp * 32) = o0; *(v4u*)(rec + GR_QD + c * 272 + grp * 32 + 16) = o1; }
#pragma unroll 1
        for (int it = lt; it < 512; it += 448) { const int dk = it >> 2, grp = it & 3;
            const u16x8 a0 = *(const LAS u16x8*)(L + GP_KT + dk * 144 + grp * 32), a1 = *(const LAS u16x8*)(L + GP_KT + dk * 144 + grp * 32 + 16); float f[16];
#pragma unroll
            for (int j = 0; j < 8; ++j) { const int c0 = grp * 16 + j, c1 = c0 + 8; f[j] = bf2f(a0[j]) * rk[c0] * __expf(glast - gcs[c0]); f[8 + j] = bf2f(a1[j]) * rk[c1] * __expf(glast - gcs[c1]); }
            *(v4u*)(rec + GR_KDT + dk * 144 + grp * 32) = mk4(pk2(f[0], f[1]), pk2(f[2], f[3]), pk2(f[8], f[9]), pk2(f[10], f[11]));
            *(v4u*)(rec + GR_KDT + dk * 144 + grp * 32 + 16) = mk4(pk2(f[4], f[5]), pk2(f[6], f[7]), pk2(f[12], f[13]), pk2(f[14], f[15])); }
        if (lt == 0) *(float*)(rec + GR_W + 256) = __expf(glast);
    }
    __syncthreads();
    { const int cb = w >> 2, vs = w & 3; f32x16 u = zero16(), wn = zero16();
      mma_nt<4>(u, L + GP_TU + cb * 32 * 144, 144, L + GP_VT + vs * 32 * 144, 144, r, h);
      mma_nt<4>(wn, L + GP_TW + cb * 32 * 144, 144, L + GP_KT + vs * 32 * 144, 144, r, h);
#pragma unroll
      for (int i = 0; i < 16; ++i) { if ((i & 1) == 0) urec[((vs * 2 + cb) * 8 + (i >> 1)) * 64 + lane] = pk2(u[i], u[i + 1]);
          *(bf16_t*)(rec + GR_W + (cb * 32 + crow(i, h)) * 272 + (vs * 32 + swz16(r)) * 2) = f2bf(-wn[i]); } }
}
constexpr int GS_BUF = 0, GS_END = 2 * GREC;
__device__ __forceinline__ void gdn_dma(const unsigned char* src, LAS unsigned char* dst, int hw, int lane, bool full) {
#pragma unroll
    for (int p = 0; p < 16; ++p) { const int piece = hw + 4 * p; if (piece < GREC / 1024 && (full || piece < GR_QD / 1024 || (piece >= GR_KDT / 1024 && piece < GR_A / 1024)))
        __builtin_amdgcn_global_load_lds((const unsigned*)(src + (size_t)piece * 1024 + lane * 16), (LAS unsigned*)(dst + piece * 1024), 16, 0, 0); }
}
__device__ __forceinline__ void gdn_seq(const Params& P, int layer, int prob, LAS unsigned char* L, int tid_in, bool dry = false) {
    bf16_t* proj = (bf16_t*)(P.ws + WS_PROJ);
    const int seg = prob % NSG, bh = prob / NSG, b = bh >> 2, hd = bh & 3, w = __builtin_amdgcn_readfirstlane(tid_in >> 6);
    const int n_full = gseg_lo(seg), n_end = gseg_lo(seg + 1);
    const unsigned char* rec0 = P.ws + WS_GT + (size_t)(bh * 64) * GREC; const unsigned* urec0 = (const unsigned*)(P.ws + WS_XB) + (size_t)(bh * 64) * 4096;
    if (w >= 4) {
        const int ht = tid_in - 256; v4u RA[16], RB[16];
#define GDN_LD(R, chunk) do { const unsigned char* src_ = rec0 + (size_t)(chunk) * GREC; _Pragma("unroll") for (int q = 0; q < 16; ++q) { const int v = (q < 15) ? ht + 256 * q : min(ht + 3840, GREC / 16 - 1); \
            R[q] = *(const v4u*)(src_ + (size_t)v * 16); } } while (0)
#define GDN_ST(R, chunk) do { LAS unsigned char* dst_ = L + GS_BUF + ((chunk) & 1) * GREC; _Pragma("unroll") for (int q = 0; q < 16; ++q) { const int v = (q < 15) ? ht + 256 * q : min(ht + 3840, GREC / 16 - 1); \
            *(LAS v4u*)(dst_ + v * 16) = R[q]; } } while (0)
        const int last = n_end - 1;
        GDN_LD(RA, 0); GDN_LD(RB, min(1, last));
        GDN_ST(RA, 0); GDN_LD(RA, min(2, last));
        WG_BAR();
#pragma unroll 1
        for (int n = 0; n < n_end; n += 2) {
            GDN_ST(RB, n + 1);
            GDN_LD(RB, min(n + 3, last));
            WG_BAR();
            GDN_ST(RA, n + 2);
            GDN_LD(RA, min(n + 4, last));
            WG_BAR();
        }
#undef GDN_LD
#undef GDN_ST
        return;
    }
    f32x16 S[4];
#pragma unroll
    for (int k = 0; k < 4; ++k) S[k] = zero16();
    unsigned ur[16];
    { const int lane = tid_in & 63;
#pragma unroll
      for (int q = 0; q < 16; ++q) ur[q] = urec0[(w * 16 + q) * 64 + lane]; }
    WG_BAR();
#pragma unroll 1
    for (int n = 0; n < n_end; ++n) {
        int tid = tid_in; asm volatile("" : "+v"(tid));
        const int lane = tid & 63, r = lane & 31, h = lane >> 5; const bool full = (n >= n_full);
        {
            const int vs = w; const LAS unsigned char* Tt = L + GS_BUF + (n & 1) * GREC;
            f32x16 vn[2];
#pragma unroll
            for (int cb = 0; cb < 2; ++cb)
#pragma unroll
                for (int i = 0; i < 16; i += 2) { const unsigned uu = ur[cb * 8 + (i >> 1)]; vn[cb][i] = __uint_as_float(uu << 16); vn[cb][i + 1] = __uint_as_float(uu & 0xffff0000u); }
            if (n + 1 < n_end) { const unsigned* up = urec0 + (size_t)(n + 1) * 4096;
#pragma unroll
                for (int q = 0; q < 16; ++q) ur[q] = up[(vs * 16 + q) * 64 + lane]; }
            bf16x8 vb[2][2];
#define GDN_STATE() do { const float dec = *(const LAS float*)(Tt + GR_W + 256); \
            _Pragma("unroll") for (int kb = 0; kb < 4; ++kb) { S[kb] = S[kb] * dec; \
                _Pragma("unroll") for (int cb = 0; cb < 2; ++cb) \
                    _Pragma("unroll") for (int s = 0; s < 2; ++s) S[kb] = MFMA32(*(const LAS bf16x8*)(Tt + GR_KDT + (kb * 32 + r) * 144 + (cb * 32 + 16 * s + 8 * h) * 2), vb[cb][s], S[kb]); } } while (0)
            f32x16 o[2]; o[0] = zero16(); o[1] = zero16();
#pragma unroll
            for (int kb = 0; kb < 4; ++kb)
#pragma unroll
                for (int s = 0; s < 2; ++s) { const bf16x8 sb = pack_acc(S[kb], s);
#pragma unroll
                    for (int cb = 0; cb < 2; ++cb) { const int off = (cb * 32 + r) * 272 + (kb * 32 + 16 * s + 8 * h) * 2;
                        vn[cb] = MFMA32(*(const LAS bf16x8*)(Tt + GR_W + off), sb, vn[cb]);
                        if (full) o[cb] = MFMA32(sb, *(const LAS bf16x8*)(Tt + GR_QD + off), o[cb]); } }
#pragma unroll
            for (int cb = 0; cb < 2; ++cb)
#pragma unroll
                for (int s = 0; s < 2; ++s) vb[cb][s] = pack_acc(vn[cb], s);
            if (full) {
#pragma unroll
                for (int c2 = 0; c2 < 2; ++c2)
#pragma unroll
                    for (int cb = 0; cb <= c2; ++cb)
#pragma unroll
                        for (int s = 0; s < 2; ++s) o[c2] = MFMA32(vb[cb][s], *(const LAS bf16x8*)(Tt + GR_A + (c2 * 32 + r) * 144 + (cb * 32 + 16 * s + 8 * h) * 2), o[c2]);
            }
            GDN_STATE();
            if (!dry && full) store_cols_bf16(proj + ((size_t)b * SEQ + (size_t)n * 64 + r) * NP + C_GV + hd * 128 + vs * 32 + 4 * h, NP, o[0], o[1]);
#undef GDN_STATE
        }
        WG_BAR();
    }
}

__device__ __forceinline__ void mix_norm(const Params& P, int layer, int gw, int NGW, int lane) {
    bf16_t* proj = (bf16_t*)(P.ws + WS_PROJ);
    float nwr[8], nws[8], nwg[8];
#pragma unroll
    for (int j = 0; j < 8; ++j) { nwr[j] = P.ret_norm_w[layer * 512 + lane * 8 + j]; nws[j] = P.ssd_norm_w[layer * 512 + lane * 8 + j]; nwg[j] = P.gdn_norm_w[layer * 128 + (lane & 15) * 8 + j]; }
#pragma unroll 2
    for (int row = gw; row < T; row += NGW) { bf16_t* pr = proj + (size_t)row * NP + lane * 8;
        const bf16_t* ysr = (const bf16_t*)(P.ws + WS_YS) + (size_t)row * 512 + lane * 8;
        const v4u yr = *(const v4u*)(pr + C_RQ), zr = *(const v4u*)(pr + C_RG), ys = *(const v4u*)ysr, zs = *(const v4u*)(pr + C_SZ), yg = *(const v4u*)(pr + C_GV), zg = *(const v4u*)(pr + C_GZ);
        float a[8], c[8], d[8], qa = 0.f, qc = 0.f, qd = 0.f;
#pragma unroll
        for (int j = 0; j < 8; ++j) { a[j] = bfsel(yr, j); qa += a[j] * a[j]; c[j] = bfsel(ys, j) * silu_f(bfsel(zs, j)); qc += c[j] * c[j]; d[j] = bfsel(yg, j); qd += d[j] * d[j]; }
#pragma unroll
        for (int o = 1; o < 16; o <<= 1) { qa += __shfl_xor(qa, o); qc += __shfl_xor(qc, o); qd += __shfl_xor(qd, o); }
        qc += __shfl_xor(qc, 16);
        const float ra = rsqrt_f(qa * (1.f / 128.f) + NORM_EPS), rc = rsqrt_f(qc * (1.f / 256.f) + NORM_EPS), rd = rsqrt_f(qd * (1.f / 128.f) + NORM_EPS);
#pragma unroll
        for (int j = 0; j < 8; ++j) { a[j] = a[j] * ra * nwr[j] * silu_f(bfsel(zr, j)); c[j] = c[j] * rc * nws[j]; d[j] = d[j] * rd * nwg[j] * silu_f(bfsel(zg, j)); }
        *(v4u*)(pr + C_RV) = mk4(pk2(a[0], a[1]), pk2(a[2], a[3]), pk2(a[4], a[5]), pk2(a[6], a[7]));
        *(v4u*)(pr + C_SX) = mk4(pk2(c[0], c[1]), pk2(c[2], c[3]), pk2(c[4], c[5]), pk2(c[6], c[7]));
        *(v4u*)(pr + C_GV) = mk4(pk2(d[0], d[1]), pk2(d[2], d[3]), pk2(d[4], d[5]), pk2(d[6], d[7])); }
}

struct Args { Params P; };
typedef const __attribute__((address_space(4))) Params* kparams_t;
__device__ __forceinline__ Params load_params() {
#if defined(__HIP_DEVICE_COMPILE__)
    kparams_t kp = (kparams_t)__builtin_amdgcn_kernarg_segment_ptr(); asm volatile("" : "+s"(kp));
    Params r; r.x = kp->x; r.pos = kp->pos; r.mix_norm_w = kp->mix_norm_w; r.w_in = kp->w_in; r.ret_norm_w = kp->ret_norm_w; r.ssd_conv_w = kp->ssd_conv_w; r.ssd_conv_b = kp->ssd_conv_b; r.ssd_dt_bias = kp->ssd_dt_bias;
    r.ssd_a_log = kp->ssd_a_log; r.ssd_d = kp->ssd_d; r.ssd_norm_w = kp->ssd_norm_w; r.gdn_conv_w = kp->gdn_conv_w; r.gdn_dt_bias = kp->gdn_dt_bias; r.gdn_a_log = kp->gdn_a_log; r.gdn_norm_w = kp->gdn_norm_w;
    r.w_out = kp->w_out; r.mlp_norm_w = kp->mlp_norm_w; r.w_up = kp->w_up; r.w_down = kp->w_down; r.final_norm_w = kp->final_norm_w; r.out = kp->out; r.ws = kp->ws; return r;
#else
    return Params{};
#endif
}

#define PHASE_FN __device__ __forceinline__ void
#define PHASE_PRO() extern __shared__ __attribute__((aligned(16))) unsigned char lds[]; LAS unsigned char* L = (LAS unsigned char*)lds; \
    int tid = threadIdx.x; asm volatile("" : "+v"(tid)); const int lane = tid & 63, wave = __builtin_amdgcn_readfirstlane(tid >> 6); const int G = gridDim.x, bx = blockIdx.x; \
    const int vcu = (G % 8 == 0) ? (bx % 8) * (G / 8) + bx / 8 : bx; const int gw = vcu * NWAVES + wave, NGW = G * NWAVES; LAS float* scr = (LAS float*)(L + RING_OFF + wave * 16384); \
    const Params P = load_params(); (void)lane; (void)gw; (void)NGW; (void)scr; (void)vcu; (void)L
#define ssa ((float*)(P.ws + WS_SSA))
#define ssb ((float*)(P.ws + WS_SSB))
#define sm ((float*)(P.ws + WS_SMALL))
#define xb ((bf16_t*)(P.ws + WS_XB))
#define proj ((bf16_t*)(P.ws + WS_PROJ))

PHASE_FN ph_grid_bar() {
    extern __shared__ __attribute__((aligned(16))) unsigned char lds[]; LAS unsigned char* L = (LAS unsigned char*)lds;
    XcdBarrier b_; b_.bar = (unsigned*)(load_params().ws + WS_CTL) + CW_BAR; b_.x = xb_xcc_id(); b_.st = (volatile LAS unsigned*)(L + MISC_OFF) + 8; xcd_barrier(b_);
}
PHASE_FN ph_p0() {
    PHASE_PRO();
    float* cs = (float*)(P.ws + WS_COS); float* sn = (float*)(P.ws + WS_SIN);
    const int gt = bx * (NWAVES * 64) + tid, ng = G * NWAVES * 64;
    for (int i = gt; i < T * 64; i += ng) {
        const int row = i >> 6, f = i & 63;
        const float inv = exp2f(-(float)f * (13.287712379549449f / 64.f));
        const float ang = (float)P.pos[row] * inv;
        double rev = (double)ang * 0.15915494309189535; rev -= floor(rev);
        const float r = (float)rev;
        cs[i] = __builtin_amdgcn_cosf(r); sn[i] = __builtin_amdgcn_sinf(r);
    }
    for (int row = gw; row < T; row += NGW) {
        const float* xr = P.x + (size_t)row * DM; float s = 0.f;
#pragma unroll
        for (int j = 0; j < DM / 256; ++j) { const float4 v = *(const float4*)(xr + j * 256 + lane * 4); s += (v.x * v.x + v.y * v.y) + (v.z * v.z + v.w * v.w);
            uint2 w; w.x = pk2(v.x, v.y); w.y = pk2(v.z, v.w); *(uint2*)(xb + (size_t)row * DM + j * 256 + lane * 4) = w; }
#pragma unroll
        for (int o = 1; o < 64; o <<= 1) s += __shfl_xor(s, o);
        if (lane < 16) ssb[(size_t)row * 16 + lane] = (lane == 0) ? s : 0.f;
    }
    convert_layer_weights(P, 0, scr, gw, NGW, lane, 1);
}
PHASE_FN ph_g1(int l) {
    PHASE_PRO(); unsigned char* wset = P.ws + WS_W + (size_t)(l & 1) * WSET;
    pg8::Gemm g{xb, (const bf16_t*)(wset + W_IN), T, NPX, DM, DM}; pg8::StaticOrder S; S.init(T, NPX, G, bx);
    pg8::EpiScaleBf16<0> E{proj, NP, ssb, (bf16_t*)(P.ws + WS_HALO), sm};
    pg8::gemm_phase<pg8::EpiScaleBf16<0>, pg8::StaticOrder, true, true>(L + RING_OFF, g, S, E);
}
PHASE_FN ph_m1(int l) {
    PHASE_PRO();
    for (int task = bx; task < NB * 4 * 64; task += G) { gdn_prep(P, l, task, L, tid); __syncthreads(); }
    for (int task = bx; task < NB * 2 * 64; task += G) { ssd_prep(P, l, task, tid); __syncthreads(); }
    for (int task = bx; task < NB * 4 * 64; task += G) { ret_prep_vt(P, task, tid); __syncthreads(); }
    ret_prep_rot(P, bx * (NWAVES * 64) + tid, G * NWAVES * 64);
}
PHASE_FN ph_m2_ret(int l) { PHASE_PRO(); ret_seq(P, l, bx, L, tid); }
PHASE_FN ph_m2_gdn(int l) { PHASE_PRO(); gdn_seq(P, l, bx - WG_RET, L, tid); }
PHASE_FN ph_m2_ssd(int l) { PHASE_PRO(); ssd_seq(P, l, bx - WG_RET - WG_GDN, L, tid); }
PHASE_FN ph_m3(int l) { PHASE_PRO(); mix_norm(P, l, gw, NGW, lane); }
PHASE_FN ph_m2_conv(int l) { PHASE_PRO(); if (l == 0) convert_layer_weights(P, 0, scr, (bx - WG_SEQ) * NWAVES + wave, (G - WG_SEQ) * NWAVES, lane, 2);
    if (l + 1 < DEPTH) convert_layer_weights(P, l + 1, scr, (bx - WG_SEQ) * NWAVES + wave, (G - WG_SEQ) * NWAVES, lane); }
PHASE_FN ph_g2(int l) {
    PHASE_PRO(); unsigned char* wset = P.ws + WS_W + (size_t)(l & 1) * WSET;
    pg8::Gemm g{proj + C_RV, (const bf16_t*)(wset + W_OUT), T, DM, MIXW, NP}; pg8::StaticOrder S; S.init(T, DM, G, bx);
    pg8::EpiRes E{(l == 0) ? P.x : (const float*)P.out, P.out, xb, ssa};
    pg8::gemm_phase<pg8::EpiRes, pg8::StaticOrder, true, true>(L + RING_OFF, g, S, E);
}
PHASE_FN ph_g3(int l) {
    PHASE_PRO(); unsigned char* wset = P.ws + WS_W + (size_t)(l & 1) * WSET;
    pg8::Gemm g{xb, (const bf16_t*)(wset + W_UP), T, DFF, DM, DM}; pg8::StaticOrder S; S.init(T, DFF, G, bx);
    pg8::EpiScaleBf16<1> E{proj, DFF, ssa, nullptr, nullptr};
    pg8::gemm_phase<pg8::EpiScaleBf16<1>, pg8::StaticOrder, true, true>(L + RING_OFF, g, S, E);
}
PHASE_FN ph_g4(int l) {
    PHASE_PRO(); unsigned char* wset = P.ws + WS_W + (size_t)(l & 1) * WSET;
    pg8::Gemm g{proj, (const bf16_t*)(wset + W_DOWN), T, DM, DFF, DFF}; pg8::StaticOrder S; S.init(T, DM, G, bx);
    pg8::EpiRes E{(const float*)P.out, P.out, xb, ssb};
    pg8::gemm_phase<pg8::EpiRes, pg8::StaticOrder, true, true>(L + RING_OFF, g, S, E);
}
PHASE_FN ph_final() {
    PHASE_PRO();
    for (int row = gw; row < T; row += NGW) {
        const float rs = row_rs(ssb, row); float* xr = P.out + (size_t)row * DM;
#pragma unroll
        for (int j = 0; j < DM / 256; ++j) { float4 v = *(float4*)(xr + j * 256 + lane * 4); const float4 w = *(const float4*)(P.final_norm_w + j * 256 + lane * 4);
            v.x *= rs * w.x; v.y *= rs * w.y; v.z *= rs * w.z; v.w *= rs * w.w; *(float4*)(xr + j * 256 + lane * 4) = v; }
    }
}
#undef ssa
#undef ssb
#undef sm
#undef xb
#undef proj


__device__ __forceinline__ void layer_body(const int l, const int bx) {
    ph_g1(l); ph_grid_bar();
    ph_m1(l); ph_grid_bar();
    if (bx < WG_RET) ph_m2_ret(l); else if (bx < WG_RET + WG_GDN) ph_m2_gdn(l); else if (bx < WG_SEQ) ph_m2_ssd(l); else if (l + 1 < DEPTH || l == 0) ph_m2_conv(l);
    ph_grid_bar();
    ph_m3(l); ph_grid_bar();
    ph_g2(l); ph_grid_bar();
    ph_g3(l); ph_grid_bar();
    ph_g4(l); ph_grid_bar();
}
__global__ void __launch_bounds__(NWAVES * 64, 2) fwd_mega(Params Pk_unused) {
    extern __shared__ __attribute__((aligned(16))) unsigned char lds[];
    LAS unsigned char* L = (LAS unsigned char*)lds;
    for (int u = threadIdx.x; u < (LDS_BYTES - LDSCTL_OFF) / 4; u += NWAVES * 64) ((LAS unsigned*)(L + LDSCTL_OFF))[u] = 0u;
    __syncthreads();
    (void)xcd_barrier_post((unsigned*)(load_params().ws + WS_CTL) + CW_BAR, (volatile LAS unsigned*)(L + MISC_OFF) + 8);
    ph_p0();
    cg::this_grid().sync();
    const int bx = blockIdx.x;
    layer_body(0, bx); layer_body(1, bx); layer_body(2, bx); layer_body(3, bx);
    ph_final();
}

extern "C" void kernel_launch(void* const* d_in, const int* in_sizes, int n_in, void* d_out, int out_size, void* d_ws, size_t ws_size, hipStream_t stream) {
    static int grid = 0;
    if (grid == 0) {
        if (n_in != 20 || out_size != T * DM || ws_size < WS_END) { fprintf(stderr, "kernel_launch: unexpected shapes n_in=%d out=%d ws=%zu (need %zu)\n", n_in, out_size, ws_size, (size_t)WS_END); grid = -1; return; }
        int dev = 0, cus = 0, per_cu = 0;
        (void)hipGetDevice(&dev); (void)hipDeviceGetAttribute(&cus, hipDeviceAttributeMultiprocessorCount, dev);
        if (hipFuncSetAttribute((const void*)fwd_mega, hipFuncAttributeMaxDynamicSharedMemorySize, LDS_BYTES) != hipSuccess) { fprintf(stderr, "kernel_launch: hipFuncSetAttribute failed\n"); grid = -1; return; }
        if (hipOccupancyMaxActiveBlocksPerMultiprocessor(&per_cu, (const void*)fwd_mega, NWAVES * 64, LDS_BYTES) != hipSuccess || per_cu < 1) { fprintf(stderr, "kernel_launch: occupancy query says %d blocks/CU\n", per_cu); (void)hipGetLastError(); grid = -1; return; }
        grid = cus;
        if (grid % 8 != 0 || grid < 64) fprintf(stderr, "kernel_launch: note: %d CUs\n", grid);
    }
    if (grid < 0) return;
    Params P{};
    P.x = (const float*)d_in[0]; P.pos = (const int*)d_in[1]; P.mix_norm_w = (const float*)d_in[2]; P.w_in = (const float*)d_in[3]; P.ret_norm_w = (const float*)d_in[4];
    P.ssd_conv_w = (const float*)d_in[5]; P.ssd_conv_b = (const float*)d_in[6]; P.ssd_dt_bias = (const float*)d_in[7]; P.ssd_a_log = (const float*)d_in[8]; P.ssd_d = (const float*)d_in[9];
    P.ssd_norm_w = (const float*)d_in[10]; P.gdn_conv_w = (const float*)d_in[11]; P.gdn_dt_bias = (const float*)d_in[12]; P.gdn_a_log = (const float*)d_in[13]; P.gdn_norm_w = (const float*)d_in[14];
    P.w_out = (const float*)d_in[15]; P.mlp_norm_w = (const float*)d_in[16]; P.w_up = (const float*)d_in[17]; P.w_down = (const float*)d_in[18]; P.final_norm_w = (const float*)d_in[19];
    P.out = (float*)d_out; P.ws = (unsigned char*)d_ws;
    if (hipMemsetAsync((char*)d_ws + WS_CTL, 0, CTL_ZERO_BYTES, stream) != hipSuccess) { fprintf(stderr, "kernel_launch: memset failed\n"); return; }
    void* args[] = {&P};
    hipError_t e = hipLaunchCooperativeKernel((const void*)fwd_mega, dim3(grid), dim3(NWAVES * 64), args, LDS_BYTES, stream);
    if (e != hipSuccess) fprintf(stderr, "kernel_launch: cooperative launch failed: %s (grid %d)\n", hipGetErrorString(e), grid);
}
```

```cpp
#include <hip/hip_runtime.h>
#include <hip/hip_cooperative_groups.h>
#include <cstdint>
#include <cstdio>
namespace cg = cooperative_groups;

typedef unsigned short bf16_t;

constexpr int NB = 4, SEQ = 4096, DM = 1024, T = NB * SEQ, DEPTH = 4;
constexpr int DIN = 5648, NP = 5632, NPX = 5888, NSMALL = 16, DFF = 4096, MIXW = 1536;
constexpr float NORM_EPS = 1e-6f, L2_EPS = 1e-6f;
constexpr int C_RQ = 0, C_RK = 512, C_RG = 1024, C_SZ = 1536, C_SB = 2048, C_SC = 2304, C_GQ = 2560, C_GK = 3072, C_GZ = 3584,
              C_RV = 4096, C_SX = 4608, C_GV = 5120;
constexpr size_t MiB = 1u << 20;
constexpr size_t WS_CTL = 0;
constexpr size_t WS_SSA = 1 * MiB;
constexpr size_t WS_SSB = 2 * MiB;
constexpr size_t WS_SMALL = 3 * MiB;
constexpr size_t WS_COS = 4 * MiB, WS_SIN = 8 * MiB;
constexpr size_t WS_W = 12 * MiB;
constexpr size_t WSET = 31 * MiB;
constexpr size_t W_IN = 0, W_OUT = 12 * MiB, W_UP = 15 * MiB, W_DOWN = 23 * MiB;
constexpr size_t WS_XB = 74 * MiB;
constexpr size_t OUT_U = 0, OUT_YS = 16 * MiB;
constexpr size_t WS_PROJ = 106 * MiB;
constexpr size_t WS_GT = 282 * MiB;
constexpr size_t WS_HALO = 343 * MiB;
constexpr size_t WS_ACS = 345 * MiB;
constexpr size_t WS_END = 346 * MiB;

struct Params {
    const float* x; const int* pos; const float* mix_norm_w; const float* w_in; const float* ret_norm_w;
    const float* ssd_conv_w; const float* ssd_conv_b; const float* ssd_dt_bias; const float* ssd_a_log; const float* ssd_d; const float* ssd_norm_w;
    const float* gdn_conv_w; const float* gdn_dt_bias; const float* gdn_a_log; const float* gdn_norm_w;
    const float* w_out; const float* mlp_norm_w; const float* w_up; const float* w_down; const float* final_norm_w;
    float* out; unsigned char* ws;
};

__device__ __forceinline__ float bf2f(bf16_t v) { return __uint_as_float((unsigned)v << 16); }
typedef float f32x2_c __attribute__((ext_vector_type(2)));
typedef __bf16 bf16x2_c __attribute__((ext_vector_type(2)));
__device__ __forceinline__ unsigned pk2(float lo, float hi) { f32x2_c v; v.x = lo; v.y = hi; return __builtin_bit_cast(unsigned, __builtin_convertvector(v, bf16x2_c)); }
__device__ __forceinline__ bf16_t f2bf(float f) { return (bf16_t)(pk2(f, f) & 0xffffu); }
__device__ __forceinline__ float silu_f(float x) { return x * __builtin_amdgcn_rcpf(1.f + __expf(-x)); }
__device__ __forceinline__ float sigmoid_f(float x) { return __builtin_amdgcn_rcpf(1.f + __expf(-x)); }
__device__ __forceinline__ float rsqrt_f(float x) { return __builtin_amdgcn_rsqf(x); }
__device__ __forceinline__ float softplus_f(float x) { return fmaxf(x, 0.f) + log1pf(__expf(-fabsf(x))); }
__device__ __forceinline__ float row_rs(const float* ssp, int row) {
    const float4* p = (const float4*)(ssp + (size_t)row * 16); const float4 a = p[0], b = p[1], c = p[2], d = p[3];
    const float s = ((a.x + a.y) + (a.z + a.w)) + ((b.x + b.y) + (b.z + b.w)) + (((c.x + c.y) + (c.z + c.w)) + ((d.x + d.y) + (d.z + d.w)));
    return rsqrt_f(s * (1.f / DM) + NORM_EPS);
}

__host__ __device__ __forceinline__ int c_new2orig(int c) {
    if (c < 1024) return c;
    if (c < 1536) return c - 1024 + 1536;
    if (c < 2048) return c - 1536 + 2048;
    if (c < 2560) return c - 2048 + 3072;
    if (c < 3584) return c - 2560 + 3592;
    if (c < 4096) return c - 3584 + 5128;
    if (c < 4608) return c - 4096 + 1024;
    if (c < 5120) return c - 4608 + 2560;
    if (c < 5632) return c - 5120 + 4616;
    if (c < 5640) return c - 5632 + 3584;
    return c - 5640 + 5640;
}


namespace pg8 {
#define PG8_LAS __attribute__((address_space(3)))
typedef unsigned short bf16_t;
typedef short bf16x8 __attribute__((ext_vector_type(8)));
typedef float f32x4 __attribute__((ext_vector_type(4)));
typedef unsigned u32x4 __attribute__((ext_vector_type(4)));
constexpr int BM = 256, BK = 64, HALF = 128, HTB = HALF * BK * 2  , STAGE_BYTES = 8 * HTB, NXCD = 8, WGM = 4;

__host__ __device__ __forceinline__ int lds_byte(int r, int c) { const int st = (r >> 4) * 2 + (c >> 5), rr = r & 15, cc = c & 31, ob = rr * 64 + cc * 2; return st * 1024 + (ob ^ (((ob >> 9) & 1) << 5)); }
__host__ __device__ __forceinline__ void stage_rc(int b, int& R, int& C) { const int st = b / 1024, sb = b % 1024, swz = sb ^ (((sb >> 9) & 1) << 5); R = (st >> 1) * 16 + swz / 64; C = (st & 1) * 32 + (swz % 64) / 2; }
__host__ __device__ __forceinline__ int perm32(int rho) { const int n = rho >> 4, i = rho & 15; return 8 * (i >> 2) + 4 * n + (i & 3); }

struct Unit { int pm, pn; };
struct Gemm { const bf16_t* A; const bf16_t* Bt; int M, N, K, lda; };

struct StaticOrder {
    int nM, nN, nwg, G, c;
    __host__ __device__ void init(int M, int N, int G_, int c_) { nM = M / BM; nN = N / BM; nwg = nM * nN; G = G_; c = c_; }
    __host__ __device__ bool next(int i, Unit& u) const {
        const long L = (long)i * G + c; if (L >= nwg) return false;
        int wgid = (int)L; { const int q = nwg / NXCD, r = nwg % NXCD, xcd = wgid % NXCD, off = wgid / NXCD; wgid = (xcd < r ? xcd * (q + 1) : r * (q + 1) + (xcd - r) * q) + off; }
        const int nig = WGM * nN, gid = wgid / nig, fm = gid * WGM, gsz = (nM - fm) < WGM ? (nM - fm) : WGM;
        u.pm = fm + ((wgid % nig) % gsz); u.pn = (wgid % nig) / gsz; return true;
    }
    __device__ __forceinline__ void a_ready(const Unit&) const {}
    __device__ __forceinline__ void done(const Unit&) const {}
};

__device__ __forceinline__ unsigned cvt_pk_bf16(float lo, float hi) { unsigned r; asm volatile("v_cvt_pk_bf16_f32 %0, %1, %2" : "=v"(r) : "v"(lo), "v"(hi)); return r; }
typedef float f32x2 __attribute__((ext_vector_type(2)));
template <class Epi, class Sched, bool ALIGN_EPI = false, bool SP2 = false>
__device__ __forceinline__ void gemm_phase(PG8_LAS unsigned char* lds, const Gemm g, const Sched& S, const Epi& E) {
    int tid_l = threadIdx.x; asm volatile("" : "+v"(tid_l));
    const int tid = tid_l, wid = __builtin_amdgcn_readfirstlane(tid >> 6), lane = tid & 63, wr = wid >> 2, wc = wid & 3, fr = lane & 15, fq = lane >> 4;
    const int K = g.K, nt = K / BK;
    unsigned voffA[2], voffB[2];
#pragma unroll
    for (int i = 0; i < 2; ++i) { int R, C; stage_rc(tid * 16 + i * 8192, R, C); const int Rb = Epi::PERM ? ((R & ~31) + perm32(R & 31)) : R;
        voffA[i] = (unsigned)(R * g.lda + C) * 2u; voffB[i] = (unsigned)(Rb * K + C) * 2u; }
    const size_t kstep = (size_t)(BK * 2);
    const size_t hstepA = (size_t)HALF * g.lda * 2, hstepB = (size_t)HALF * K * 2;
    const size_t tstepA = 2 * hstepA, tstepB = 2 * hstepB;
    const unsigned ldsw = (unsigned)wid * 1024u;
    const int aoff = lds_byte(wr * 64 + fr, fq * 8), boff = lds_byte(wc * 32 + fr, fq * 8);
#define PG8_SA(b, h) (((b) * 2 + (h)) * HTB)
#define PG8_SB(b, h) ((4 + (b) * 2 + (h)) * HTB)
#define PG8_STAGE(bufoff, gbase, voff) do { _Pragma("unroll") for (int _i = 0; _i < 2; ++_i) \
        __builtin_amdgcn_global_load_lds((const unsigned*)((const char*)(gbase) + (voff)[_i]), (PG8_LAS unsigned*)(lds + (bufoff) + ldsw + _i * 8192), 16, 0, 0); } while (0)
#define PG8_LDA(dst, b, h) do { _Pragma("unroll") for (int m = 0; m < 4; ++m) _Pragma("unroll") for (int k = 0; k < 2; ++k) dst[m][k] = *(const PG8_LAS bf16x8*)(lds + PG8_SA(b, h) + aoff + m * 2048 + k * 1024); } while (0)
#define PG8_LDB(dst, b, h) do { _Pragma("unroll") for (int n = 0; n < 2; ++n) _Pragma("unroll") for (int k = 0; k < 2; ++k) dst[n][k] = *(const PG8_LAS bf16x8*)(lds + PG8_SB(b, h) + boff + n * 2048 + k * 1024); } while (0)
#define PG8_MMA(ai, bj, At, Bt) do { __builtin_amdgcn_s_setprio(1); _Pragma("unroll") for (int m = 0; m < 4; ++m) _Pragma("unroll") for (int n = 0; n < 2; ++n) _Pragma("unroll") for (int k = 0; k < 2; ++k) \
        acc[ai][bj][m][n] = __builtin_amdgcn_mfma_f32_16x16x32_bf16(Bt[n][k], At[m][k], acc[ai][bj][m][n], 0, 0, 0); __builtin_amdgcn_s_setprio(0); } while (0)
#define PG8_WAIT_V(n) asm volatile("s_waitcnt vmcnt(" #n ")" ::: "memory")
#define PG8_WAIT_L(n) asm volatile("s_waitcnt lgkmcnt(" #n ")" ::: "memory")
#define PG8_BAR __builtin_amdgcn_s_barrier()
#define PG8_SCHED __builtin_amdgcn_sched_barrier(0)
    Unit cur, nxt; int ui = 0;
    if (!S.next(0, cur)) return;
    f32x4 acc[2][2][4][2];
#pragma unroll
    for (int a = 0; a < 2; ++a)
#pragma unroll
        for (int b = 0; b < 2; ++b)
#pragma unroll
            for (int m = 0; m < 4; ++m)
#pragma unroll
                for (int n = 0; n < 2; ++n) acc[a][b][m][n] = (f32x4){0.f, 0.f, 0.f, 0.f};
    bf16x8 At[4][2], B0[2][2], B1[2][2];
    const char* cA = (const char*)g.A + (size_t)cur.pm * tstepA; const char* cB = (const char*)g.Bt + (size_t)cur.pn * tstepB;
    S.a_ready(cur);
    if constexpr (SP2) {
        PG8_STAGE(PG8_SB(0, 0), cB, voffB); PG8_STAGE(PG8_SB(0, 1), cB + hstepB, voffB); PG8_STAGE(PG8_SA(0, 0), cA, voffA); PG8_STAGE(PG8_SA(0, 1), cA + hstepA, voffA);
        if (wr == 1) PG8_BAR;
        PG8_WAIT_V(2); PG8_BAR;
        PG8_STAGE(PG8_SB(1, 0), cB + kstep, voffB); PG8_STAGE(PG8_SA(1, 0), cA + kstep, voffA); PG8_STAGE(PG8_SB(1, 1), cB + hstepB + kstep, voffB);
        PG8_WAIT_V(6); PG8_BAR;
    } else {
        PG8_STAGE(PG8_SB(0, 0), cB, voffB); PG8_STAGE(PG8_SA(0, 0), cA, voffA); PG8_STAGE(PG8_SB(0, 1), cB + hstepB, voffB); PG8_STAGE(PG8_SA(0, 1), cA + hstepA, voffA);
        if (wr == 1) PG8_BAR;
        PG8_WAIT_V(4); PG8_BAR;
        PG8_STAGE(PG8_SB(1, 0), cB + kstep, voffB); PG8_STAGE(PG8_SA(1, 0), cA + kstep, voffA); PG8_STAGE(PG8_SB(1, 1), cB + hstepB + kstep, voffB);
        PG8_WAIT_V(6); PG8_BAR;
    }
    for (;;) {
        const bool has_next = S.next(ui + 1, nxt);
        const char* nA = has_next ? (const char*)g.A + (size_t)nxt.pm * tstepA : cA; const char* nB = has_next ? (const char*)g.Bt + (size_t)nxt.pn * tstepB : cB;
        for (int t = 0; t < nt; t += 2) {
            const bool last = (t == nt - 2);
            const char* a1 = cA + (size_t)(t + 1) * kstep;
            const char* a2 = last ? nA : cA + (size_t)(t + 2) * kstep; const char* b2 = last ? nB : cB + (size_t)(t + 2) * kstep;
            const char* a3 = a2 + kstep; const char* b3 = b2 + kstep;
            if (last && has_next) S.a_ready(nxt);
            if constexpr (SP2) {
            PG8_LDB(B0, 0, 0); PG8_LDB(B1, 0, 1); PG8_SCHED; PG8_LDA(At, 0, 0); PG8_STAGE(PG8_SA(1, 1), a1 + hstepA, voffA);
            PG8_WAIT_V(8); PG8_WAIT_L(0); PG8_BAR; PG8_MMA(0, 0, At, B0); PG8_MMA(0, 1, At, B1); PG8_BAR; PG8_SCHED;
            PG8_LDA(At, 0, 1); PG8_STAGE(PG8_SB(0, 0), b2, voffB); PG8_STAGE(PG8_SB(0, 1), b2 + hstepB, voffB); PG8_STAGE(PG8_SA(0, 0), a2, voffA);
            PG8_WAIT_V(8); PG8_WAIT_L(0); PG8_BAR; PG8_MMA(1, 0, At, B0); PG8_MMA(1, 1, At, B1); PG8_BAR; PG8_SCHED;
            PG8_LDB(B0, 1, 0); PG8_LDB(B1, 1, 1); PG8_SCHED; PG8_LDA(At, 1, 0); PG8_STAGE(PG8_SA(0, 1), a2 + hstepA, voffA);
            PG8_WAIT_V(8); PG8_WAIT_L(0); PG8_BAR; PG8_MMA(0, 0, At, B0); PG8_MMA(0, 1, At, B1); PG8_BAR; PG8_SCHED;
            PG8_LDA(At, 1, 1); PG8_STAGE(PG8_SB(1, 0), b3, voffB); PG8_STAGE(PG8_SB(1, 1), b3 + hstepB, voffB); PG8_STAGE(PG8_SA(1, 0), a3, voffA);
            PG8_WAIT_V(8); PG8_WAIT_L(0); PG8_BAR; PG8_MMA(1, 0, At, B0); PG8_MMA(1, 1, At, B1); PG8_BAR; PG8_SCHED;
            } else {
            PG8_LDB(B0, 0, 0); PG8_SCHED; PG8_LDA(At, 0, 0); PG8_STAGE(PG8_SA(1, 1), a1 + hstepA, voffA);
            PG8_WAIT_L(8); PG8_BAR; PG8_WAIT_L(0); PG8_MMA(0, 0, At, B0); PG8_BAR; PG8_SCHED;
            PG8_LDB(B1, 0, 1); PG8_STAGE(PG8_SB(0, 0), b2, voffB);
            PG8_BAR; PG8_WAIT_L(0); PG8_MMA(0, 1, At, B1); PG8_BAR;
            PG8_LDA(At, 0, 1); PG8_STAGE(PG8_SA(0, 0), a2, voffA);
            PG8_BAR; PG8_WAIT_L(0); PG8_MMA(1, 0, At, B0); PG8_BAR; PG8_SCHED;
            PG8_STAGE(PG8_SB(0, 1), b2 + hstepB, voffB);
            PG8_WAIT_V(6); PG8_BAR; PG8_MMA(1, 1, At, B1); PG8_BAR;
            PG8_LDB(B0, 1, 0); PG8_SCHED; PG8_LDA(At, 1, 0); PG8_STAGE(PG8_SA(0, 1), a2 + hstepA, voffA);
            PG8_WAIT_L(8); PG8_BAR; PG8_WAIT_L(0); PG8_MMA(0, 0, At, B0); PG8_BAR; PG8_SCHED;
            PG8_LDB(B1, 1, 1); PG8_STAGE(PG8_SB(1, 0), b3, voffB);
            PG8_BAR; PG8_WAIT_L(0); PG8_MMA(0, 1, At, B1); PG8_BAR;
            PG8_LDA(At, 1, 1); PG8_STAGE(PG8_SA(1, 0), a3, voffA);
            PG8_BAR; PG8_WAIT_L(0); PG8_MMA(1, 0, At, B0); PG8_BAR; PG8_SCHED;
            PG8_STAGE(PG8_SB(1, 1), b3 + hstepB, voffB);
            PG8_WAIT_V(6); PG8_BAR; PG8_MMA(1, 1, At, B1); PG8_BAR;
            }
        }
        if constexpr (ALIGN_EPI) { if (wr == 0) PG8_BAR; }
        if constexpr (!Epi::AFTER_DRAIN) { E(acc, cur, wr, wc, fr, fq); S.done(cur); }
        if (!has_next) break;
#pragma unroll
        for (int a = 0; a < 2; ++a)
#pragma unroll
            for (int b = 0; b < 2; ++b)
#pragma unroll
                for (int m = 0; m < 4; ++m)
#pragma unroll
                    for (int n = 0; n < 2; ++n) acc[a][b][m][n] = (f32x4){0.f, 0.f, 0.f, 0.f};
        cur = nxt; cA = nA; cB = nB; ++ui;
        if constexpr (ALIGN_EPI) { if (wr == 1) PG8_BAR; }
    }
    PG8_WAIT_V(0);
    if constexpr (!ALIGN_EPI) { if (wr == 0) PG8_BAR; }
    PG8_BAR;
    if constexpr (Epi::AFTER_DRAIN) { E.fused(acc, cur, wr, wc, fr, fq, lds, wid, lane); S.done(cur); }
#undef PG8_SA
#undef PG8_SB
#undef PG8_STAGE
#undef PG8_LDA
#undef PG8_LDB
#undef PG8_MMA
#undef PG8_WAIT_V
#undef PG8_WAIT_L
#undef PG8_BAR
#undef PG8_SCHED
}
}

namespace pg8 {
template <int ACT> struct EpiScaleBf16 {
    static constexpr bool PERM = true, AFTER_DRAIN = false;
    bf16_t* O; int ldc; const float* ssp; bf16_t* halo; float* small;
    __device__ __forceinline__ void operator()(const f32x4 (&acc)[2][2][4][2], const Unit& u, int wr, int wc, int fr, int fq) const {
        const int row0 = u.pm * BM + wr * 64 + fr, col0 = u.pn * BM + wc * 32 + 8 * fq;
        float rsv[8];
#pragma unroll
        for (int k = 0; k < 8; ++k) { const f32x4 p = *(const f32x4*)(ssp + (size_t)(row0 + (k >> 2) * HALF + (k & 3) * 16) * 16 + 4 * fq); rsv[k] = (p[0] + p[1]) + (p[2] + p[3]); }
#pragma unroll
        for (int k = 0; k < 8; ++k) { float t = rsv[k]; t += __shfl_xor(t, 16); t += __shfl_xor(t, 32); rsv[k] = rsqrt_f(t * (1.f / DM) + NORM_EPS); }
#pragma unroll
        for (int ai = 0; ai < 2; ++ai)
#pragma unroll
            for (int m = 0; m < 4; ++m) { const int row = row0 + ai * HALF + m * 16; const float rs = rsv[ai * 4 + m]; bf16_t* rowp = O + (size_t)row * ldc + col0;
#pragma unroll
                for (int bj = 0; bj < 2; ++bj) { f32x4 v0 = acc[ai][bj][m][0] * rs, v1 = acc[ai][bj][m][1] * rs;
                    if (ACT == 0 && u.pn == NP / BM) {
                        if (bj == 0 && wc == 0 && fq < 2) { *(f32x4*)(small + (size_t)row * 16 + 8 * fq) = v0; *(f32x4*)(small + (size_t)row * 16 + 8 * fq + 4) = v1; }
                        continue; }
                    if (ACT == 1) {
#pragma unroll
                        for (int i = 0; i < 4; ++i) { const float a = fmaxf(v0[i], 0.f), b = fmaxf(v1[i], 0.f); v0[i] = a * a; v1[i] = b * b; } }
                    u32x4 w; w.x = cvt_pk_bf16(v0[0], v0[1]); w.y = cvt_pk_bf16(v0[2], v0[3]); w.z = cvt_pk_bf16(v1[0], v1[1]); w.w = cvt_pk_bf16(v1[2], v1[3]);
                    *(u32x4*)(rowp + bj * HALF) = w;
                    if (ACT == 0 && m == 3) { if (halo && fr >= 13 && (u.pn == 8 || u.pn == 9 || u.pn == 18 || u.pn == 19)) { const int col = col0 + bj * HALF;
                        const int ch = (u.pn < 10) ? (512 + col - C_SB) : (col - C_SX);
                        *(u32x4*)(halo + ((size_t)(row >> 6) * 3 + (fr - 13)) * 1024 + ch) = w; } } } }
    }
};
struct EpiRes {
    static constexpr bool PERM = true, AFTER_DRAIN = false;
    bf16_t* xb; float* ss_out;
    __device__ __forceinline__ void operator()(const f32x4 (&acc)[2][2][4][2], const Unit& u, int wr, int wc, int fr, int fq) const {
        const int row0 = u.pm * BM + wr * 64 + fr, col0 = u.pn * BM + wc * 32 + 8 * fq;
#pragma unroll
        for (int ai = 0; ai < 2; ++ai)
#pragma unroll
            for (int m = 0; m < 4; ++m) { const int row = row0 + ai * HALF + m * 16; bf16_t* rowp = xb + (size_t)row * DM + col0; float sq = 0.f;
#pragma unroll
                for (int bj = 0; bj < 2; ++bj) { const u32x4 bv = *(const u32x4*)(rowp + bj * HALF); const f32x4 a0 = acc[ai][bj][m][0], a1 = acc[ai][bj][m][1];
                    u32x4 w; w.x = cvt_pk_bf16(__uint_as_float(bv.x << 16) + a0[0], __uint_as_float(bv.x & 0xffff0000u) + a0[1]); w.y = cvt_pk_bf16(__uint_as_float(bv.y << 16) + a0[2], __uint_as_float(bv.y & 0xffff0000u) + a0[3]);
                    w.z = cvt_pk_bf16(__uint_as_float(bv.z << 16) + a1[0], __uint_as_float(bv.z & 0xffff0000u) + a1[1]); w.w = cvt_pk_bf16(__uint_as_float(bv.w << 16) + a1[2], __uint_as_float(bv.w & 0xffff0000u) + a1[3]);
                    *(u32x4*)(rowp + bj * HALF) = w;
#pragma unroll
                    for (int i = 0; i < 4; ++i) { const float lo = __uint_as_float(w[i] << 16), hi = __uint_as_float(w[i] & 0xffff0000u); sq += lo * lo + hi * hi; } }
                sq += __shfl_xor(sq, 16); sq += __shfl_xor(sq, 32);
                if (fq == 0) ss_out[(size_t)row * 16 + u.pn * 4 + wc] = sq; }
    }
};
}

#define GAS __attribute__((address_space(1)))
#define LAS __attribute__((address_space(3)))
constexpr int NWAVES = 8;
constexpr int RING_OFF = 0, RING_BYTES = 131072;
constexpr int LDSCTL_OFF = 161792, MISC_OFF = LDSCTL_OFF + 320;
constexpr int LDS_BYTES = 163840;
constexpr int CW_BAR = 4096;
constexpr size_t CTL_ZERO_BYTES = 64 * 1024;
typedef unsigned v4u __attribute__((ext_vector_type(4)));
#define LDS_WAIT() asm volatile("s_waitcnt lgkmcnt(0)" ::: "memory")
#define XB_TMO      128
#define XB_XCNT(j)  (256  + 64 * (j))
#define XB_XSUB(j)  (1280 + 64 * (j))
#define XB_XGEN(j)  (2304 + 64 * (j))
#define XB_TOP      3328
#define XB_TOPGEN   3392
#define XCD_BAR_WORDS 3456
#define XB_SPIN_CAP (1u << 18)

__device__ __forceinline__ unsigned xb_ld(unsigned* p)              { return __hip_atomic_load(p, __ATOMIC_RELAXED, __HIP_MEMORY_SCOPE_AGENT); }
__device__ __forceinline__ unsigned xb_add(unsigned* p, unsigned v) { return __hip_atomic_fetch_add(p, v, __ATOMIC_RELAXED, __HIP_MEMORY_SCOPE_AGENT); }
__device__ __forceinline__ unsigned xb_xcc_id() { return (unsigned)__builtin_amdgcn_s_getreg((3 << 11) | 20) & 0xFu; }
#define XB_SPIN(cond, bar) do { unsigned _sp = 0; while (cond) { __builtin_amdgcn_s_sleep(1); \
    if ((++_sp & 255u) == 0u) { if (xb_ld(&(bar)[XB_TMO])) break; if (_sp > XB_SPIN_CAP) { atomicAdd(&(bar)[XB_TMO], 1u); break; } } } } while (0)

struct XcdBarrier {
    unsigned* bar; unsigned x;
    volatile LAS unsigned* st;
};

__device__ __forceinline__ XcdBarrier xcd_barrier_post(unsigned* bar, volatile LAS unsigned* st) {
    XcdBarrier b; b.bar = bar; b.x = xb_xcc_id(); b.st = st;
    if (threadIdx.x == 0) (void)xb_add(&bar[XB_XCNT(b.x)], 1u);
    return b;
}
__device__ __forceinline__ void xcd_barrier_complete(unsigned* bar, unsigned x, unsigned& nloc, unsigned& nx) {
    const unsigned G = gridDim.x * gridDim.y * gridDim.z;
    unsigned sum, cnt, mine, sp = 0u;
    for (;;) {
        sum = 0u; cnt = 0u; mine = 0u;
#pragma unroll
        for (unsigned j = 0; j < 16; ++j) { const unsigned c = xb_ld(&bar[XB_XCNT(j)]); sum += c; cnt += (c > 0u) ? 1u : 0u; mine = (j == x) ? c : mine; }
        if (sum == G) break;
        __builtin_amdgcn_s_sleep(1);
        if ((++sp & 255u) == 0u) { if (xb_ld(&bar[XB_TMO])) break; if (sp > XB_SPIN_CAP) { atomicAdd(&bar[XB_TMO], 1u); break; } }
    }
    nloc = mine > 0u ? mine : 1u; nx = cnt > 0u ? cnt : 1u;
}

__device__ __forceinline__ void xcd_barrier(const XcdBarrier& b) {
    asm volatile("s_waitcnt vmcnt(0)" ::: "memory");
    __syncthreads();
    if (threadIdx.x == 0) {
        unsigned* bar = b.bar;
        __builtin_amdgcn_s_waitcnt(0);
        unsigned nloc = b.st[0], nx = b.st[1];
        if (nloc == 0u) { xcd_barrier_complete(bar, b.x, nloc, nx); b.st[0] = nloc; b.st[1] = nx; }
        const unsigned old = xb_add(&bar[XB_XSUB(b.x)], 1u);
        const unsigned gen = old / nloc;
        if (old + 1u == (gen + 1u) * nloc) {
            __builtin_amdgcn_fence(__ATOMIC_RELEASE, "agent");
            asm volatile("s_waitcnt vmcnt(0)" ::: "memory");
            const unsigned og = xb_add(&bar[XB_TOP], 1u);
            const unsigned tg = og / nx;
            if (og + 1u == (tg + 1u) * nx) xb_add(&bar[XB_TOPGEN], 1u);
            else XB_SPIN(xb_ld(&bar[XB_TOPGEN]) == tg, bar);
            __builtin_amdgcn_fence(__ATOMIC_ACQUIRE, "agent");
            xb_add(&bar[XB_XGEN(b.x)], 1u);
            asm volatile("s_waitcnt vmcnt(0)" ::: "memory");
        } else {
            XB_SPIN(xb_ld(&bar[XB_XGEN(b.x)]) == gen, bar);
            __builtin_amdgcn_fence(__ATOMIC_ACQUIRE, "agent");
            asm volatile("s_waitcnt vmcnt(0)" ::: "memory");
        }
    }
    __syncthreads();
}

template <bool MAPIN> __device__ __forceinline__ void transpose_item(const float* W, int K, int Nsrc, int Ndst, int Nvalid, const float* kscale, bf16_t* WT, LAS float* scr, int item, int lane) {
    const int nblk = (Ndst + 31) / 32, kb = item / nblk, nb = item % nblk, k0 = 64 * kb, n0 = 32 * nb;
    const int nn = n0 + (lane & 31); const bool ok = nn < Nvalid; const int sc = MAPIN ? c_new2orig(ok ? nn : 0) : nn;
#pragma unroll 8
    for (int i = 0; i < 32; ++i) { const int kk = 2 * i + (lane >> 5); float v = ok ? __builtin_nontemporal_load(&W[(size_t)(k0 + kk) * Nsrc + sc]) : 0.f; if (kscale) v *= kscale[k0 + kk]; scr[kk * 33 + (lane & 31)] = v; }
    LDS_WAIT(); asm volatile("" ::: "memory");
    const int c = lane & 7;
#pragma unroll
    for (int j = 0; j < 4; ++j) { const int n = (lane >> 3) + 8 * j; const LAS float* s = scr + (8 * c) * 33 + n;
        v4u o; o.x = pk2(s[0 * 33], s[1 * 33]); o.y = pk2(s[2 * 33], s[3 * 33]); o.z = pk2(s[4 * 33], s[5 * 33]); o.w = pk2(s[6 * 33], s[7 * 33]);
        if (n0 + n < Ndst) *(v4u*)(WT + (size_t)(n0 + n) * K + k0 + 8 * c) = o; }
    LDS_WAIT(); asm volatile("" ::: "memory");
}
__device__ __forceinline__ void convert_layer_weights(const Params& P, int layer, LAS float* scr, int gw, int NGW, int lane, int which = 0) {
    unsigned char* wset = P.ws + WS_W + (size_t)(layer & 1) * WSET;
    constexpr int I_IN = (DM / 64) * (NPX / 32), I_OUT = (MIXW / 64) * (DM / 32), I_UP = (DM / 64) * (DFF / 32), I_DN = (DFF / 64) * (DM / 32);
    const int lo = (which == 2) ? I_IN : 0, hi = (which == 1) ? I_IN : I_IN + I_OUT + I_UP + I_DN;
    for (int it = lo + gw; it < hi; it += NGW) {
        int r = it;
        if (r < I_IN) { transpose_item<true>(P.w_in + (size_t)layer * DM * DIN, DM, DIN, NPX, DIN, P.mix_norm_w + layer * DM, (bf16_t*)(wset + W_IN), scr, r, lane); continue; } r -= I_IN;
        if (r < I_OUT) { transpose_item<false>(P.w_out + (size_t)layer * MIXW * DM, MIXW, DM, DM, DM, nullptr, (bf16_t*)(wset + W_OUT), scr, r, lane); continue; } r -= I_OUT;
        if (r < I_UP) { transpose_item<false>(P.w_up + (size_t)layer * DM * DFF, DM, DFF, DFF, DFF, P.mlp_norm_w + layer * DM, (bf16_t*)(wset + W_UP), scr, r, lane); continue; } r -= I_UP;
        transpose_item<false>(P.w_down + (size_t)layer * DFF * DM, DFF, DM, DM, DM, nullptr, (bf16_t*)(wset + W_DOWN), scr, r, lane);
    }
}
typedef short bf16x8 __attribute__((ext_vector_type(8)));
typedef float f32x16 __attribute__((ext_vector_type(16)));
typedef unsigned short u16x8 __attribute__((ext_vector_type(8)));
typedef unsigned v2u __attribute__((ext_vector_type(2)));
typedef float f32x4_t __attribute__((ext_vector_type(4)));
__device__ __forceinline__ v4u mk4(unsigned a, unsigned b, unsigned c, unsigned d) { v4u r; r.x = a; r.y = b; r.z = c; r.w = d; return r; }
#define MFMA32(a, b, c) __builtin_amdgcn_mfma_f32_32x32x16_bf16((a), (b), (c), 0, 0, 0)
__device__ __forceinline__ int crow(int i, int h) { return (i & 3) + 8 * (i >> 2) + 4 * h; }
__device__ __forceinline__ int kswz(int row) { return ((row & 3) << 2) | ((row >> 2) & 3); }
__device__ __forceinline__ void mma_nt_swzb(f32x16& acc, const LAS unsigned char* A, int lda, const LAS unsigned char* Bt, int r, int h) {
    const int sw = kswz(r);
#pragma unroll
    for (int ks = 0; ks < 8; ++ks) {
        const bf16x8 a = *(const LAS bf16x8*)(A + r * lda + ks * 32 + h * 16);
        const bf16x8 b = *(const LAS bf16x8*)(Bt + r * 256 + (((2 * ks + h) ^ sw) << 4));
        acc = MFMA32(a, b, acc);
    }
}
template <int KS> __device__ __forceinline__ void mma_nt(f32x16& acc, const LAS unsigned char* A, int lda, const LAS unsigned char* Bt, int ldb, int r, int h) {
#pragma unroll
    for (int ks = 0; ks < KS; ++ks) {
        const bf16x8 a = *(const LAS bf16x8*)(A + r * lda + ks * 32 + h * 16);
        const bf16x8 b = *(const LAS bf16x8*)(Bt + r * ldb + ks * 32 + h * 16);
        acc = MFMA32(a, b, acc);
    }
}
__device__ __forceinline__ void store_acc_T(const f32x16& v, LAS unsigned char* dst, int ldt, int r, int h) {
#pragma unroll
    for (int g = 0; g < 4; ++g) { v2u w; w.x = pk2(v[4 * g], v[4 * g + 1]); w.y = pk2(v[4 * g + 2], v[4 * g + 3]); *(LAS v2u*)(dst + r * ldt + (8 * g + 4 * h) * 2) = w; }
}
__device__ __forceinline__ float bfsel(const v4u& v, int c) { const unsigned u = v[c >> 1]; return __uint_as_float((c & 1) ? (u & 0xffff0000u) : (u << 16)); }
__device__ __forceinline__ f32x16 zero16() { f32x16 z;
#pragma unroll
    for (int i = 0; i < 16; ++i) z[i] = 0.f; return z; }

__device__ __forceinline__ bf16x8 pack_acc(const f32x16& x, int s) {
    v4u p; p.x = pk2(x[8 * s], x[8 * s + 1]); p.y = pk2(x[8 * s + 2], x[8 * s + 3]); p.z = pk2(x[8 * s + 4], x[8 * s + 5]); p.w = pk2(x[8 * s + 6], x[8 * s + 7]);
    return __builtin_bit_cast(bf16x8, p);
}
__device__ __forceinline__ void store_rows_bf16(bf16_t* base_row4h, const int pitch, const f32x16& y0, const f32x16& y1) {
    bf16_t* p = base_row4h;
#pragma unroll
    for (int cb = 0; cb < 2; ++cb)
#pragma unroll
        for (int g = 0; g < 4; ++g) { asm volatile("" : "+v"(p));
#pragma unroll
            for (int q = 0; q < 4; ++q) { p[(size_t)q * pitch] = f2bf(cb == 0 ? y0[4 * g + q] : y1[4 * g + q]); }
            p += (size_t)8 * pitch; }
}
typedef short s16x4 __attribute__((ext_vector_type(4)));
__device__ __forceinline__ bf16x8 tr_frag(const LAS unsigned char* p, const int stride) {
    const s16x4 a = __builtin_amdgcn_ds_read_tr16_b64_v4i16((LAS s16x4*)p), b = __builtin_amdgcn_ds_read_tr16_b64_v4i16((LAS s16x4*)(p + 4 * stride));
    return __builtin_shufflevector(a, b, 0, 1, 2, 3, 4, 5, 6, 7);
}
__device__ __forceinline__ bf16x8 tr_frag2(const LAS unsigned char* p0, const LAS unsigned char* p1) {
    const s16x4 a = __builtin_amdgcn_ds_read_tr16_b64_v4i16((LAS s16x4*)p0), b = __builtin_amdgcn_ds_read_tr16_b64_v4i16((LAS s16x4*)p1);
    return __builtin_shufflevector(a, b, 0, 1, 2, 3, 4, 5, 6, 7);
}
#define KSWZ_TR_BASES(base, tile) do { const int q_ = (lane & 15) >> 2, blk_ = (lane >> 4) & 1, p_ = lane & 3; \
        _Pragma("unroll") for (int kb = 0; kb < 4; ++kb) _Pragma("unroll") for (int t = 0; t < 2; ++t) \
            base[kb][t] = (tile) + (8 * h + 4 * t + q_) * 256 + ((((kb * 4) + 2 * blk_ + (p_ >> 1)) ^ ((q_ << 2) | (2 * h + t))) << 4) + (p_ & 1) * 8; } while (0)
__device__ __forceinline__ void store_cols_bf16(bf16_t* base, const size_t pitch, const f32x16& y0, const f32x16& y1) {
    typedef __attribute__((address_space(1))) v2u* gp_t;
#pragma unroll
    for (int lb = 0; lb < 2; ++lb)
#pragma unroll
        for (int g = 0; g < 4; ++g) { v2u o; o.x = lb == 0 ? pk2(y0[4 * g], y0[4 * g + 1]) : pk2(y1[4 * g], y1[4 * g + 1]); o.y = lb == 0 ? pk2(y0[4 * g + 2], y0[4 * g + 3]) : pk2(y1[4 * g + 2], y1[4 * g + 3]);
            *(gp_t)(base + (size_t)lb * 32 * pitch + 8 * g) = o; }
}
#define WG_BAR() do { asm volatile("s_waitcnt lgkmcnt(0)" ::: "memory"); __builtin_amdgcn_s_barrier(); asm volatile("" ::: "memory"); } while (0)
__device__ __forceinline__ void ret_prep_rot(const Params& P, int gt, int ng) {
    bf16_t* proj = (bf16_t*)(P.ws + WS_PROJ); const float* cs = (const float*)(P.ws + WS_COS); const float* sn = (const float*)(P.ws + WS_SIN);
#pragma unroll 1
    for (int idx0 = gt; idx0 < T * 32; idx0 += 2 * ng) {
        v4u q1[2], q2[2], k1[2], k2[2]; f32x4_t c0[2], c1[2], s0[2], s1[2];
#pragma unroll
        for (int u = 0; u < 2; ++u) { const int idx = min(idx0 + u * ng, T * 32 - 1), row = idx >> 5, hd = (idx >> 3) & 3, i0 = (idx & 7) * 8;
            const bf16_t* pr = proj + (size_t)row * NP + hd * 128 + i0;
            q1[u] = *(const v4u*)(pr + C_RQ); q2[u] = *(const v4u*)(pr + C_RQ + 64); k1[u] = *(const v4u*)(pr + C_RK); k2[u] = *(const v4u*)(pr + C_RK + 64);
            c0[u] = *(const f32x4_t*)(cs + (size_t)row * 64 + i0); c1[u] = *(const f32x4_t*)(cs + (size_t)row * 64 + i0 + 4); s0[u] = *(const f32x4_t*)(sn + (size_t)row * 64 + i0); s1[u] = *(const f32x4_t*)(sn + (size_t)row * 64 + i0 + 4); }
#pragma unroll
        for (int u = 0; u < 2; ++u) { const int idx = idx0 + u * ng; if (idx < T * 32) { const int row = idx >> 5, hd = (idx >> 3) & 3, i0 = (idx & 7) * 8;
            bf16_t* pr = proj + (size_t)row * NP + hd * 128 + i0;
            const float cc[8] = {c0[u][0], c0[u][1], c0[u][2], c0[u][3], c1[u][0], c1[u][1], c1[u][2], c1[u][3]}, ss_[8] = {s0[u][0], s0[u][1], s0[u][2], s0[u][3], s1[u][0], s1[u][1], s1[u][2], s1[u][3]};
            const float lg = log2f(1.f - exp2f(-5.f - (float)hd)), zeta = __builtin_amdgcn_exp2f((float)(63 - (row & 63)) * lg);
            float qa[8], qb[8], ka[8], kb[8];
#pragma unroll
            for (int j = 0; j < 8; ++j) { const float a1 = bfsel(q1[u], j), a2 = bfsel(q2[u], j), b1 = bfsel(k1[u], j), b2 = bfsel(k2[u], j);
                qa[j] = (a1 * cc[j] - a2 * ss_[j]) * 0.08838834764831845f; qb[j] = (a2 * cc[j] + a1 * ss_[j]) * 0.08838834764831845f; ka[j] = (b1 * cc[j] - b2 * ss_[j]) * zeta; kb[j] = (b2 * cc[j] + b1 * ss_[j]) * zeta; }
            *(v4u*)(pr + C_RQ) = mk4(pk2(qa[0], qa[1]), pk2(qa[2], qa[3]), pk2(qa[4], qa[5]), pk2(qa[6], qa[7]));
            *(v4u*)(pr + C_RQ + 64) = mk4(pk2(qb[0], qb[1]), pk2(qb[2], qb[3]), pk2(qb[4], qb[5]), pk2(qb[6], qb[7]));
            *(v4u*)(pr + C_RK) = mk4(pk2(ka[0], ka[1]), pk2(ka[2], ka[3]), pk2(ka[4], ka[5]), pk2(ka[6], ka[7]));
            *(v4u*)(pr + C_RK + 64) = mk4(pk2(kb[0], kb[1]), pk2(kb[2], kb[3]), pk2(kb[4], kb[5]), pk2(kb[6], kb[7])); } }
    }
}
__device__ __forceinline__ void ret_prep_vt(const Params& P, int task0, int task1, int tid) {
    bf16_t* proj = (bf16_t*)(P.ws + WS_PROJ);
    const int e = tid & 127, tg = tid >> 7;
    v4u o0[2], o1[2];
#pragma unroll
    for (int k = 0; k < 2; ++k) { const int task = (k == 0 || task1 < 0) ? task0 : task1, bh = task >> 6, n = task & 63, b = bh >> 2, hd = bh & 3;
        const bf16_t* base = proj + ((size_t)b * SEQ + n * 64) * NP + C_RV + hd * 128;
        unsigned short v[16];
#pragma unroll
        for (int j = 0; j < 16; ++j) v[j] = base[(size_t)(16 * tg + j) * NP + e];
        o0[k] = mk4(v[0] | ((unsigned)v[1] << 16), v[2] | ((unsigned)v[3] << 16), v[4] | ((unsigned)v[5] << 16), v[6] | ((unsigned)v[7] << 16));
        o1[k] = mk4(v[8] | ((unsigned)v[9] << 16), v[10] | ((unsigned)v[11] << 16), v[12] | ((unsigned)v[13] << 16), v[14] | ((unsigned)v[15] << 16)); }
    __syncthreads();
#pragma unroll
    for (int k = 0; k < 2; ++k) { const int task = (k == 0) ? task0 : task1; if (task >= 0) { const int bh = task >> 6, n = task & 63, b = bh >> 2, hd = bh & 3;
        bf16_t* dst = proj + ((size_t)b * SEQ + n * 64) * NP + C_RV + hd * 128 + (size_t)(e >> 1) * NP + (e & 1) * 64 + 16 * tg;
        *(v4u*)dst = o0[k]; *(v4u*)(dst + 8) = o1[k]; } }
}
constexpr int NSR = 2, NSS = 2, NSG = 2, RSPLIT = 42, SSPLIT = 36;
constexpr int WG_RET = 16 * NSR, WG_GDN = 16 * NSG, WG_SSD = 32 * NSS, WG_SEQ = WG_RET + WG_GDN + WG_SSD;
__device__ __forceinline__ int rseg_lo(int s) { return NSR == 1 ? (s == 0 ? 0 : 64) : NSR == 2 ? (s == 0 ? 0 : (s == 1 ? RSPLIT : 64)) : (s == 0 ? 0 : (s == 1 ? 32 : (s == 2 ? 52 : 64))); }
__device__ __forceinline__ int gseg_lo(int s) { return NSG == 1 ? (s == 0 ? 0 : 64) : (s == 0 ? 0 : (s == 1 ? 46 : 64)); }
__device__ __forceinline__ int sseg_lo(int s) { return NSS == 1 ? (s == 0 ? 0 : 64) : NSS == 2 ? (s == 0 ? 0 : (s == 1 ? SSPLIT : 64)) : (s == 0 ? 0 : (s == 1 ? 32 : (s == 2 ? 52 : 64))); }
constexpr int RS_Q = 0, RS_P = 17408, RS_V = 26624, RS_K = 45056, RS_BUF = 62464, RS_END = 2 * RS_BUF;
__device__ __forceinline__ void ret_seq(const Params& P, int layer, int prob, LAS unsigned char* L, int tid_in, bool dry = false) {
    bf16_t* proj = (bf16_t*)(P.ws + WS_PROJ);
    const int seg = prob % NSR, b = (prob / NSR) >> 2, hd = (prob / NSR) & 3, w = __builtin_amdgcn_readfirstlane(tid_in >> 6);
    const int n_full = rseg_lo(seg), n_end = rseg_lo(seg + 1);
    const float lg = log2f(1.f - exp2f(-5.f - (float)hd));
    const size_t rowb = (size_t)b * SEQ;
    if (w >= 4) {
        const int ht = tid_in - 256, last = n_end - 1;
        v4u PFA[12], PFB[12];
#define RET_LD(PF, chunk) do { const int c_ = min((chunk), last), cq_ = max(c_, n_full); const bf16_t* rk_ = proj + (rowb + (size_t)c_ * 64) * NP + hd * 128; const bf16_t* rq_ = proj + (rowb + (size_t)cq_ * 64) * NP + hd * 128; \
            _Pragma("unroll") for (int q = 0; q < 12; ++q) { const int vv = ht + 256 * (q & 3); const size_t o_ = (size_t)(vv >> 4) * NP + (vv & 15) * 8; \
                PF[q] = *(const v4u*)((q < 4) ? rq_ + C_RQ + o_ : ((q < 8) ? rk_ + C_RK + o_ : rk_ + C_RV + o_)); } } while (0)
#define RET_HBODY(n_, PF) do { const int n = (n_); int tid = tid_in; asm volatile("" : "+v"(tid)); const int lane = tid & 63, r = lane & 31, h = lane >> 5; \
            LAS unsigned char* Tn = L + ((n + 1) & 1) * RS_BUF; const bool fulln = (n + 1 >= n_full);     \
            _Pragma("unroll") for (int q = 0; q < 12; ++q) { const int vv = (tid - 256) + 256 * (q & 3), row = vv >> 4, c0 = (vv & 15) * 8; \
                *(LAS v4u*)((q < 4) ? Tn + RS_Q + row * 272 + c0 * 2 : ((q < 8) ? Tn + RS_K + row * 256 + (((vv & 15) ^ kswz(row)) << 4) : Tn + RS_V + (2 * row + (c0 >> 6)) * 144 + (c0 & 63) * 2)) = PF[q]; }     \
            if (n + 1 >= n_full) WG_BAR();     \
            if (n + 1 < n_end && fulln && w < 7) {     \
                const int t = w - 4, ib = (t + 1) >> 1, jb = t >> 1; f32x16 sacc = zero16(); \
                mma_nt_swzb(sacc, Tn + RS_Q + ib * 32 * 272, 272, Tn + RS_K + jb * 32 * 256, r, h); \
                const int jj = jb * 32 + r; \
                _Pragma("unroll") for (int i = 0; i < 16; ++i) { const int ii = ib * 32 + crow(i, h); \
                    *(LAS bf16_t*)(Tn + RS_P + ii * 144 + jj * 2) = f2bf((ii >= jj) ? sacc[i] * __builtin_amdgcn_exp2f((float)(ii - 63) * lg) : 0.f); } } \
            RET_LD(PF, n + 3);     \
            WG_BAR();     } while (0)
        RET_LD(PFA, 0); RET_LD(PFB, 1);
        RET_HBODY(-1, PFA);
#pragma unroll 1
        for (int m = 0; m < n_end; m += 2) { RET_HBODY(m, PFB); RET_HBODY(m + 1, PFA); }
#undef RET_LD
#undef RET_HBODY
        return;
    }
    const int vs = w; const float cdec = exp2f(64.f * lg);
    f32x16 S[4];
#pragma unroll
    for (int k = 0; k < 4; ++k) S[k] = zero16();
#pragma unroll 1
    for (int n = -1; n < n_end; ++n) {
        int tid = tid_in; asm volatile("" : "+v"(tid));
        const int lane = tid & 63, r = lane & 31, h = lane >> 5;
        const LAS unsigned char* Tt = L + (n & 1) * RS_BUF; const bool full = (n >= n_full);
#define RET_STATE() do { const LAS unsigned char* kp[4][2]; KSWZ_TR_BASES(kp, Tt + RS_K); \
            _Pragma("unroll") for (int kb = 0; kb < 4; ++kb) S[kb] = S[kb] * cdec; \
            _Pragma("unroll") for (int ks = 0; ks < 4; ++ks) { const bf16x8 vb = *(const LAS bf16x8*)(Tt + RS_V + (vs * 32 + r) * 144 + (ks * 16 + 8 * h) * 2); \
                _Pragma("unroll") for (int kb = 0; kb < 4; ++kb) S[kb] = MFMA32(tr_frag2(kp[kb][0] + ks * 4096, kp[kb][1] + ks * 4096), vb, S[kb]); } } while (0)
        if (n >= 0 && full) {
            f32x16 y[2];
            v4u qf[16];
#pragma unroll
            for (int i = 0; i < 16; ++i) { const LAS unsigned char* ap = Tt + RS_Q + ((i & 1) * 32 + r) * 272 + ((i >> 1) * 16 + 4 * h) * 2;
                const v2u a0 = *(const LAS v2u*)ap, a1 = *(const LAS v2u*)(ap + 16); qf[i].x = a0.x; qf[i].y = a0.y; qf[i].z = a1.x; qf[i].w = a1.y; }
            __builtin_amdgcn_sched_barrier(0);
#pragma unroll
            for (int kb = 0; kb < 4; ++kb)
#pragma unroll
                for (int s = 0; s < 2; ++s) { const bf16x8 sa = pack_acc(S[kb], s);
#pragma unroll
                    for (int lb = 0; lb < 2; ++lb) y[lb] = (kb == 0 && s == 0) ? MFMA32(sa, __builtin_bit_cast(bf16x8, qf[lb]), zero16()) : MFMA32(sa, __builtin_bit_cast(bf16x8, qf[(kb * 2 + s) * 2 + lb]), y[lb]); }
#pragma unroll
            for (int lb = 0; lb < 2; ++lb) y[lb] = y[lb] * __builtin_amdgcn_exp2f((float)(lb * 32 + r + 1) * lg);
            WG_BAR();
#pragma unroll
            for (int lb = 0; lb < 2; ++lb)
#pragma unroll
                for (int ks = 0; ks < 4; ++ks) { if (ks >= 2 * lb + 2) continue;
                    y[lb] = MFMA32(*(const LAS bf16x8*)(Tt + RS_V + (vs * 32 + r) * 144 + (ks * 16 + 8 * h) * 2), *(const LAS bf16x8*)(Tt + RS_P + (lb * 32 + r) * 144 + (ks * 16 + 8 * h) * 2), y[lb]); }
            RET_STATE();
            if (!dry) store_cols_bf16(proj + (rowb + (size_t)n * 64 + r) * NP + C_RQ + hd * 128 + vs * 32 + 4 * h, NP, y[0], y[1]);
        } else {
            if (n + 1 >= n_full) WG_BAR();
            if (n >= 0) RET_STATE();
        }
#undef RET_STATE
        WG_BAR();
    }
}
__device__ __forceinline__ void ret_norm(const Params& P, int layer, int gt, int ng) {
    bf16_t* proj = (bf16_t*)(P.ws + WS_PROJ);
    for (int it = gt; it < T * 4 * 16; it += ng) { const int item = it >> 4, cg = it & 15, row = item >> 2, hd = item & 3;
        bf16_t* yp = proj + (size_t)row * NP + C_RV + hd * 128 + cg * 8;
        const u16x8 yv = *(const u16x8*)yp; const u16x8 zv = *(const u16x8*)(proj + (size_t)row * NP + C_RG + hd * 128 + cg * 8);
        float v[8], sq = 0.f;
#pragma unroll
        for (int j = 0; j < 8; ++j) { v[j] = bf2f(yv[j]); sq += v[j] * v[j]; }
        sq += __shfl_xor(sq, 1); sq += __shfl_xor(sq, 2); sq += __shfl_xor(sq, 4); sq += __shfl_xor(sq, 8);
        const float rs = rsqrt_f(sq * (1.f / 128.f) + NORM_EPS); const float* nwp = P.ret_norm_w + layer * 512 + hd * 128 + cg * 8;
#pragma unroll
        for (int j = 0; j < 8; ++j) v[j] = v[j] * rs * nwp[j] * silu_f(bf2f(zv[j]));
        *(v4u*)yp = mk4(pk2(v[0], v[1]), pk2(v[2], v[3]), pk2(v[4], v[5]), pk2(v[6], v[7])); }
}

__device__ __forceinline__ void gdn_norm(const Params& P, int layer, int gt, int ng) {
    bf16_t* proj = (bf16_t*)(P.ws + WS_PROJ);
    for (int it = gt; it < T * 4 * 16; it += ng) { const int item = it >> 4, cg = it & 15, row = item >> 2, hd = item & 3;
        bf16_t* yp = proj + (size_t)row * NP + C_GV + hd * 128 + cg * 8;
        const u16x8 yv = *(const u16x8*)yp; const u16x8 zv = *(const u16x8*)(proj + (size_t)row * NP + C_GZ + hd * 128 + cg * 8);
        float v[8], sq = 0.f;
#pragma unroll
        for (int j = 0; j < 8; ++j) { v[j] = bf2f(yv[j]); sq += v[j] * v[j]; }
        sq += __shfl_xor(sq, 1); sq += __shfl_xor(sq, 2); sq += __shfl_xor(sq, 4); sq += __shfl_xor(sq, 8);
        const float rs = rsqrt_f(sq * (1.f / 128.f) + NORM_EPS); const float* nwp = P.gdn_norm_w + layer * 128 + cg * 8;
#pragma unroll
        for (int j = 0; j < 8; ++j) v[j] = v[j] * rs * nwp[j] * silu_f(bf2f(zv[j]));
        *(v4u*)yp = mk4(pk2(v[0], v[1]), pk2(v[2], v[3]), pk2(v[4], v[5]), pk2(v[6], v[7])); }
}
#define SSD_PREP_LD(R, task_, tid_) do { const bf16_t* proj_ = (const bf16_t*)(P.ws + WS_PROJ); const bf16_t* halo_ = (const bf16_t*)(P.ws + WS_HALO); \
        const int b_ = (task_) >> 7, g_ = ((task_) >> 6) & 1, n_ = (task_) & 63, w_ = (tid_) >> 6, cgp_ = (tid_) & 63; const size_t row0_ = (size_t)b_ * SEQ + n_ * 64; const int chunk_ = b_ * 64 + n_; \
        const int colb_ = (cgp_ < 32) ? (C_SX + g_ * 256 + 8 * cgp_) : ((cgp_ < 48) ? (C_SB + g_ * 128 + 8 * (cgp_ - 32)) : (C_SC + g_ * 128 + 8 * (cgp_ - 48))); \
        const int chb_ = (cgp_ < 32) ? (g_ * 256 + 8 * cgp_) : ((cgp_ < 48) ? (512 + g_ * 128 + 8 * (cgp_ - 32)) : (768 + g_ * 128 + 8 * (cgp_ - 48))); \
        _Pragma("unroll") for (int j = 0; j < 11; ++j) { const int tokrel_ = 8 * w_ + j - 3; \
            const bf16_t* p_ = (tokrel_ >= 0) ? proj_ + (row0_ + tokrel_) * NP + colb_ : ((n_ > 0) ? halo_ + ((size_t)(chunk_ - 1) * 3 + j) * 1024 + chb_ : proj_ + row0_ * NP + colb_); \
            R[j] = *(const v4u*)p_; } } while (0)
__device__ __forceinline__ void ssd_prep(const Params& P, int layer, int task, int tid, v4u (&R)[11]) {
    bf16_t* proj = (bf16_t*)(P.ws + WS_PROJ); float* sm = (float*)(P.ws + WS_SMALL); float* acsb = (float*)(P.ws + WS_ACS); const bf16_t* halo = (const bf16_t*)(P.ws + WS_HALO);
    const int b = task >> 7, g = (task >> 6) & 1, n = task & 63, w = __builtin_amdgcn_readfirstlane(tid >> 6), cgp = tid & 63, lane = tid & 63;
    const size_t row0 = (size_t)b * SEQ + n * 64; const int chunk = b * 64 + n;
    const int colb = (cgp < 32) ? (C_SX + g * 256 + 8 * cgp) : ((cgp < 48) ? (C_SB + g * 128 + 8 * (cgp - 32)) : (C_SC + g * 128 + 8 * (cgp - 48)));
    const int chb = (cgp < 32) ? (g * 256 + 8 * cgp) : ((cgp < 48) ? (512 + g * 128 + 8 * (cgp - 32)) : (768 + g * 128 + 8 * (cgp - 48)));
#pragma unroll
    for (int j = 0; j < 3; ++j) { const int tokrel = 8 * w + j - 3; if (tokrel < 0 && n == 0) R[j] = mk4(0u, 0u, 0u, 0u); }
    const float* cw = P.ssd_conv_w + (size_t)layer * 4 * 1024 + chb; const float* cbp = P.ssd_conv_b + layer * 1024 + chb;
    v4u tokv[8];
#pragma unroll
    for (int j = 0; j < 8; ++j) tokv[j] = mk4(0u, 0u, 0u, 0u);
    v4u chv[8];
#pragma unroll
    for (int c = 0; c < 8; ++c) { const float w0 = cw[c], w1 = cw[1024 + c], w2 = cw[2048 + c], w3 = cw[3072 + c], bs = cbp[c]; float o[8];
#pragma unroll
        for (int j = 0; j < 8; ++j) { const float a = w0 * bfsel(R[j], c) + w1 * bfsel(R[j + 1], c) + w2 * bfsel(R[j + 2], c) + w3 * bfsel(R[j + 3], c) + bs;
            o[j] = a * __builtin_amdgcn_rcpf(1.f + __expf(-a)); }
        chv[c] = mk4(pk2(o[0], o[1]), pk2(o[2], o[3]), pk2(o[4], o[5]), pk2(o[6], o[7]));
#pragma unroll
        for (int j = 0; j < 8; ++j) { const unsigned hv = (chv[c][j >> 1] >> (16 * (j & 1))) & 0xffffu; tokv[j][c >> 1] |= hv << (16 * (c & 1)); } }
    float dtv = 0.f, acv = 0.f;
    if (w < 4) {
        const int hg = 4 * g + w; dtv = softplus_f(sm[(row0 + lane) * 16 + hg] + P.ssd_dt_bias[layer * 8 + hg]); acv = dtv * -__expf(P.ssd_a_log[layer * 8 + hg]);
#pragma unroll
        for (int o = 1; o < 64; o <<= 1) { const float t = __shfl_up(acv, o); if (lane >= o) acv += t; } }
    __syncthreads();
    if (cgp < 32) {
#pragma unroll
        for (int c = 0; c < 8; ++c) { const int p = 8 * cgp + c; *(v4u*)(proj + (row0 + (p & 63)) * NP + C_SX + g * 256 + (p >> 6) * 64 + 8 * w) = chv[c]; } }
    else {
#pragma unroll
        for (int j = 0; j < 8; ++j) *(v4u*)(proj + (row0 + 8 * w + j) * NP + colb) = tokv[j]; }
    if (w < 4) { sm[(row0 + lane) * 16 + 4 * g + w] = dtv; acsb[(row0 + lane) * 8 + 4 * g + w] = acv; }
}
constexpr int SQ_C = 0, SQ_W = 17408, SQ_X = 26624, SQ_B = 35840, SQ_A = 53248, SQ_BUF = 54528, SQ_END = 2 * SQ_BUF;
__device__ __forceinline__ void ssd_seq(const Params& P, int layer, int prob, LAS unsigned char* L, int tid_in, bool dry = false) {
    bf16_t* proj = (bf16_t*)(P.ws + WS_PROJ); const float* sm = (const float*)(P.ws + WS_SMALL); const float* acsb = (const float*)(P.ws + WS_ACS);
    const int seg = prob % NSS, b = (prob / NSS) >> 3, hg = (prob / NSS) & 7, g = hg >> 2, hh = hg & 3, w = __builtin_amdgcn_readfirstlane(tid_in >> 6);
    const int n_full = sseg_lo(seg), n_end = sseg_lo(seg + 1);
    const size_t rowb = (size_t)b * SEQ;
    if (w >= 2) {
        const int ht = tid_in - 128, last = n_end - 1; const float dsk = P.ssd_d[layer * 8 + hg];
        v4u PFA[8], PFB[8]; float paA, pdA, paB, pdB;
        int soff[3], doff[3];
#pragma unroll
        for (int j = 0; j < 3; ++j) { const int vv = min(ht + 384 * j, 1023); soff[j] = (vv >> 4) * NP + (vv & 15) * 8; doff[j] = (vv >> 4) * 272 + (vv & 15) * 16; }
        int dbo[3];
#pragma unroll
        for (int j = 0; j < 3; ++j) { const int vv = min(ht + 384 * j, 1023); dbo[j] = (vv >> 4) * 256 + (((vv & 15) ^ kswz(vv >> 4)) << 4); }
        int sxo[2], dxo[2];
#pragma unroll
        for (int j = 0; j < 2; ++j) { const int vv = min(ht + 384 * j, 511); sxo[j] = (vv >> 3) * NP + (vv & 7) * 8; dxo[j] = (vv >> 3) * 144 + (vv & 7) * 16; }
#define SSD_LD(PF, pa, pd, chunk) do { const int c_ = min((chunk), last), cq_ = max(c_, n_full); const size_t r0_ = rowb + (size_t)c_ * 64, rq_ = rowb + (size_t)cq_ * 64; \
            pa = acsb[(r0_ + (ht & 63)) * 8 + hg]; pd = sm[(r0_ + (ht & 63)) * 16 + hg]; \
            const bf16_t* pc_ = proj + rq_ * NP + C_SC + g * 128; const bf16_t* pb_ = proj + r0_ * NP + C_SB + g * 128; const bf16_t* px_ = proj + r0_ * NP + C_SX + g * 256 + hh * 64; \
            _Pragma("unroll") for (int q = 0; q < 8; ++q) PF[q] = *(const v4u*)((q < 3) ? pc_ + soff[q] : ((q < 6) ? pb_ + soff[q - 3] : px_ + sxo[q - 6])); } while (0)
#define SSD_HBODY(n_, PF, pa, pd) do { const int n = (n_); int tid = tid_in; asm volatile("" : "+v"(tid)); const int lane = tid & 63, r = lane & 31, h = lane >> 5; \
            LAS unsigned char* Tn = L + ((n + 1) & 1) * SQ_BUF;         \
            const bool fulln = (n + 1 >= n_full);                       \
            _Pragma("unroll") for (int q = 0; q < 8; ++q) *(LAS v4u*)((q < 3) ? Tn + SQ_C + doff[q] : ((q < 6) ? Tn + SQ_B + dbo[q - 3] : Tn + SQ_X + dxo[q - 6])) = PF[q]; \
            if (w == 7) { const float a_end = __shfl(pa, 63);     \
                *(LAS float*)(Tn + SQ_A + lane * 4) = pa; *(LAS float*)(Tn + SQ_A + 256 + lane * 4) = pd; \
                *(LAS float*)(Tn + SQ_A + 512 + lane * 4) = __expf(pa); *(LAS float*)(Tn + SQ_A + 768 + lane * 4) = pd * __expf(a_end - pa); \
                if (lane == 63) *(LAS float*)(Tn + SQ_A + 1024) = __expf(pa); } \
            if (n + 1 >= n_full) WG_BAR();     \
            if (n + 1 < n_end && fulln && w < 5) {     \
                const int t = w - 2, ib = (t + 1) >> 1, jb = t >> 1; f32x16 sacc = zero16(); \
                mma_nt_swzb(sacc, Tn + SQ_C + ib * 32 * 272, 272, Tn + SQ_B + jb * 32 * 256, r, h); \
                const LAS float* acs = (const LAS float*)(Tn + SQ_A); const LAS float* dtv = acs + 64; \
                const int m = jb * 32 + r; const float am = acs[m], dm = dtv[m]; \
                _Pragma("unroll") for (int i = 0; i < 16; ++i) { const int l = ib * 32 + crow(i, h); float v = (m <= l) ? sacc[i] * __expf(acs[l] - am) * dm : 0.f; if (m == l) v += dsk; \
                    *(LAS bf16_t*)(Tn + SQ_W + l * 144 + m * 2) = f2bf(v); } } \
            SSD_LD(PF, pa, pd, n + 3);     \
            WG_BAR();     } while (0)
        SSD_LD(PFA, paA, pdA, 0); SSD_LD(PFB, paB, pdB, 1);
        SSD_HBODY(-1, PFA, paA, pdA);
#pragma unroll 1
        for (int m = 0; m < n_end; m += 2) { SSD_HBODY(m, PFB, paB, pdB); SSD_HBODY(m + 1, PFA, paA, pdA); }
#undef SSD_LD
#undef SSD_HBODY
        return;
    }
    const int pb = w;
    f32x16 st[4];
#pragma unroll
    for (int k = 0; k < 4; ++k) st[k] = zero16();
#pragma unroll 1
    for (int n = -1; n < n_end; ++n) {
        int tid = tid_in; asm volatile("" : "+v"(tid));
        const int lane = tid & 63, r = lane & 31, h = lane >> 5; const bool full = (n >= n_full);
        const LAS unsigned char* Tt = L + (n & 1) * SQ_BUF; const LAS float* acs = (const LAS float*)(Tt + SQ_A);
#define SSD_STATE() do { const float cd = acs[256]; \
            const LAS unsigned char* bp[4][2]; KSWZ_TR_BASES(bp, Tt + SQ_B); \
            _Pragma("unroll") for (int kb = 0; kb < 4; ++kb) st[kb] = st[kb] * cd; \
            _Pragma("unroll") for (int ks = 0; ks < 4; ++ks) { const int m0 = ks * 16 + 8 * h; \
                const u16x8 xr = *(const LAS u16x8*)(Tt + SQ_X + (pb * 32 + r) * 144 + m0 * 2); \
                const f32x4_t f0 = *(const LAS f32x4_t*)(acs + 192 + m0), f1 = *(const LAS f32x4_t*)(acs + 196 + m0); \
                const v4u xv = mk4(pk2(bf2f(xr[0]) * f0[0], bf2f(xr[1]) * f0[1]), pk2(bf2f(xr[2]) * f0[2], bf2f(xr[3]) * f0[3]), pk2(bf2f(xr[4]) * f1[0], bf2f(xr[5]) * f1[1]), pk2(bf2f(xr[6]) * f1[2], bf2f(xr[7]) * f1[3])); \
                _Pragma("unroll") for (int kb = 0; kb < 4; ++kb) st[kb] = MFMA32(tr_frag2(bp[kb][0] + ks * 4096, bp[kb][1] + ks * 4096), __builtin_bit_cast(bf16x8, xv), st[kb]); } } while (0)
        if (n >= 0 && full) {
            f32x16 y[2];
            v4u cf[16];
#pragma unroll
            for (int i = 0; i < 16; ++i) { const LAS unsigned char* ap = Tt + SQ_C + ((i & 1) * 32 + r) * 272 + ((i >> 1) * 16 + 4 * h) * 2;
                const v2u a0 = *(const LAS v2u*)ap, a1 = *(const LAS v2u*)(ap + 16); cf[i].x = a0.x; cf[i].y = a0.y; cf[i].z = a1.x; cf[i].w = a1.y; }
            const float e0 = acs[128 + r], e1 = acs[160 + r];
            __builtin_amdgcn_sched_barrier(0);
#pragma unroll
            for (int kb = 0; kb < 4; ++kb)
#pragma unroll
                for (int s = 0; s < 2; ++s) { const bf16x8 sa = pack_acc(st[kb], s);
#pragma unroll
                    for (int lb = 0; lb < 2; ++lb) y[lb] = (kb == 0 && s == 0) ? MFMA32(sa, __builtin_bit_cast(bf16x8, cf[lb]), zero16()) : MFMA32(sa, __builtin_bit_cast(bf16x8, cf[(kb * 2 + s) * 2 + lb]), y[lb]); }
            y[0] = y[0] * e0; y[1] = y[1] * e1;
            WG_BAR();
#pragma unroll
            for (int lb = 0; lb < 2; ++lb)
#pragma unroll
                for (int ks = 0; ks < 4; ++ks) { if (ks >= 2 * lb + 2) continue;
                    y[lb] = MFMA32(*(const LAS bf16x8*)(Tt + SQ_X + (pb * 32 + r) * 144 + (ks * 16 + 8 * h) * 2), *(const LAS bf16x8*)(Tt + SQ_W + (lb * 32 + r) * 144 + (ks * 16 + 8 * h) * 2), y[lb]); }
            SSD_STATE();
            if (!dry) store_cols_bf16((bf16_t*)((unsigned char*)P.out + OUT_YS) + (rowb + (size_t)n * 64 + r) * 512 + g * 256 + hh * 64 + pb * 32 + 4 * h, 512, y[0], y[1]);
        } else {
            if (n + 1 >= n_full) WG_BAR();
            if (n >= 0) SSD_STATE();
        }
#undef SSD_STATE
        WG_BAR();
    }
}
__device__ __forceinline__ void ssd_norm(const Params& P, int layer, int gt, int ng) {
    bf16_t* proj = (bf16_t*)(P.ws + WS_PROJ);
    for (int it = gt; it < T * 2 * 32; it += ng) { const int item = it >> 5, cg = it & 31, row = item >> 1, g = item & 1;
        bf16_t* yp = proj + (size_t)row * NP + C_SX + g * 256 + cg * 8;
        const u16x8 yv = *(const u16x8*)yp; const u16x8 zv = *(const u16x8*)(proj + (size_t)row * NP + C_SZ + g * 256 + cg * 8);
        float v[8], sq = 0.f;
#pragma unroll
        for (int j = 0; j < 8; ++j) { v[j] = bf2f(yv[j]) * silu_f(bf2f(zv[j])); sq += v[j] * v[j]; }
        sq += __shfl_xor(sq, 1); sq += __shfl_xor(sq, 2); sq += __shfl_xor(sq, 4); sq += __shfl_xor(sq, 8); sq += __shfl_xor(sq, 16);
        const float rs = rsqrt_f(sq * (1.f / 256.f) + NORM_EPS); const float* nwp = P.ssd_norm_w + layer * 512 + g * 256 + cg * 8;
#pragma unroll
        for (int j = 0; j < 8; ++j) v[j] *= rs * nwp[j];
        *(v4u*)yp = mk4(pk2(v[0], v[1]), pk2(v[2], v[3]), pk2(v[4], v[5]), pk2(v[6], v[7])); }
}

constexpr int GREC = 62464, GR_W = 0, GR_QD = 17408, GR_KDT = 34816, GR_A = 53248;
constexpr int GP_Q = 0, GP_K = 17408, GP_KT = 34816, GP_VT = 53248, GP_L = 71680, GP_TU = 88064, GP_TW = 97280, GP_RQ = 106496, GP_RK = 106752, GP_GCS = 107008, GP_BETA = 107264, GP_END = 107520;
__device__ __forceinline__ int swz16(int k) { return (k & ~12) | ((k & 4) << 1) | ((k & 8) >> 1); }
#define GDN_PREP_LD(R, task_, tid_) do { const bf16_t* proj_ = (const bf16_t*)(P.ws + WS_PROJ); const int b_ = (task_) >> 8, hd_ = ((task_) >> 6) & 3, t0_ = ((task_) & 63) * 64; const size_t row0_ = (size_t)b_ * SEQ + t0_; \
        const int cgq_ = (tid_) % 48, tg_ = (tid_) / 48, type_ = cgq_ >> 4, d0_ = (cgq_ & 15) * 8; const int col_ = (type_ == 0 ? C_GQ : (type_ == 1 ? C_GK : C_GV)) + hd_ * 128 + d0_; \
        _Pragma("unroll") for (int j = 0; j < 11; ++j) { const int tokrel_ = 8 * tg_ + j - 3; const int tr_ = (tokrel_ >= 0 || t0_ > 0) ? tokrel_ : 0; \
            R[j] = *(const v4u*)(proj_ + (row0_ + tr_) * NP + col_); } } while (0)
__device__ __forceinline__ void gdn_prep(const Params& P, int layer, int task, LAS unsigned char* L, int tid_in, v4u (&R)[11], int next_task) {
    int tid = tid_in; asm volatile("" : "+v"(tid));
    const bf16_t* proj = (const bf16_t*)(P.ws + WS_PROJ); const float* sm = (const float*)(P.ws + WS_SMALL);
    const int b = task >> 8, hd = (task >> 6) & 3, n = task & 63, t0 = n * 64, lane = tid & 63, w = __builtin_amdgcn_readfirstlane(tid >> 6), r = lane & 31, h = lane >> 5;
    const size_t row0 = (size_t)b * SEQ + t0;
    unsigned char* rec = P.ws + WS_GT + (size_t)task * GREC; unsigned* urec = (unsigned*)((unsigned char*)P.out + OUT_U) + (size_t)task * 4096;
    if (w < 6) {
        const int cgq = tid % 48, tg = tid / 48, type = cgq >> 4, d0 = (cgq & 15) * 8;
        const int col = (type == 0 ? C_GQ : (type == 1 ? C_GK : C_GV)) + hd * 128 + d0, ch = type * 512 + hd * 128 + d0;
#pragma unroll
        for (int j = 0; j < 3; ++j) { const int tokrel = 8 * tg + j - 3; if (!(tokrel >= 0 || t0 > 0)) R[j] = mk4(0u, 0u, 0u, 0u); }
        const float* cw = P.gdn_conv_w + (size_t)layer * 4 * 1536 + ch;
        v4u tokv[8];
#pragma unroll
        for (int j = 0; j < 8; ++j) tokv[j] = mk4(0u, 0u, 0u, 0u);
#pragma unroll
        for (int c = 0; c < 8; ++c) { const float w0 = cw[c], w1 = cw[1536 + c], w2 = cw[3072 + c], w3 = cw[4608 + c]; float o[8];
#pragma unroll
            for (int j = 0; j < 8; ++j) o[j] = silu_f(w0 * bfsel(R[j], c) + w1 * bfsel(R[j + 1], c) + w2 * bfsel(R[j + 2], c) + w3 * bfsel(R[j + 3], c));
            const v4u chv = mk4(pk2(o[0], o[1]), pk2(o[2], o[3]), pk2(o[4], o[5]), pk2(o[6], o[7]));
            if (type == 1) *(LAS v4u*)(L + GP_KT + (d0 + c) * 144 + tg * 16) = chv;
            else if (type == 2) *(LAS v4u*)(L + GP_VT + (d0 + c) * 144 + tg * 16) = chv;
            if (type < 2) {
#pragma unroll
                for (int j = 0; j < 8; ++j) { const unsigned hv = (chv[j >> 1] >> (16 * (j & 1))) & 0xffffu; tokv[j][c >> 1] |= hv << (16 * (c & 1)); } } }
        if (type < 2) {
#pragma unroll
            for (int j = 0; j < 8; ++j) *(LAS v4u*)(L + (type == 0 ? GP_Q : GP_K) + (8 * tg + j) * 272 + d0 * 2) = tokv[j]; }
        GDN_PREP_LD(R, next_task, tid);
    } else if (w == 6) {
        const float beta = sigmoid_f(sm[(row0 + lane) * 16 + 8 + hd]);
        float c = -__expf(P.gdn_a_log[layer * 4 + hd]) * softplus_f(sm[(row0 + lane) * 16 + 12 + hd] + P.gdn_dt_bias[layer * 4 + hd]);
#pragma unroll
        for (int o = 1; o < 64; o <<= 1) { const float t = __shfl_up(c, o); if (lane >= o) c += t; }
        *(LAS float*)(L + GP_GCS + lane * 4) = c; *(LAS float*)(L + GP_BETA + lane * 4) = beta;
    }
    WG_BAR();
    { const int tok = tid >> 3, part = tid & 7; float sq = 0.f, sk = 0.f;
#pragma unroll
      for (int v = 0; v < 2; ++v) { const u16x8 a = *(const LAS u16x8*)(L + GP_Q + tok * 272 + part * 32 + v * 16), c = *(const LAS u16x8*)(L + GP_K + tok * 272 + part * 32 + v * 16);
#pragma unroll
          for (int j = 0; j < 8; ++j) { const float x = bf2f(a[j]), y = bf2f(c[j]); sq += x * x; sk += y * y; } }
      sq += __shfl_xor(sq, 1); sq += __shfl_xor(sq, 2); sq += __shfl_xor(sq, 4); sk += __shfl_xor(sk, 1); sk += __shfl_xor(sk, 2); sk += __shfl_xor(sk, 4);
      if (part == 0) { *(LAS float*)(L + GP_RQ + tok * 4) = (rsqrt_f(sq + L2_EPS)) * 0.08838834764831845f; *(LAS float*)(L + GP_RK + tok * 4) = rsqrt_f(sk + L2_EPS); } }
    WG_BAR();
    const LAS float* rq = (const LAS float*)(L + GP_RQ); const LAS float* rk = (const LAS float*)(L + GP_RK); const LAS float* gcs = (const LAS float*)(L + GP_GCS); const LAS float* bet = (const LAS float*)(L + GP_BETA);
    const float glast = gcs[63];
    if (w < 6) {
        const int t = (w < 3) ? w : w - 3, ib = (t + 1) >> 1, jb = t >> 1; f32x16 s = zero16();
        mma_nt<8>(s, L + ((w < 3) ? GP_K : GP_Q) + ib * 32 * 272, 272, L + GP_K + jb * 32 * 272, 272, r, h);
        const int jj = jb * 32 + r; const float rkj = rk[jj], gj = gcs[jj];
#pragma unroll
        for (int i = 0; i < 16; ++i) { const int ii = ib * 32 + crow(i, h); const float e = __expf(gcs[ii] - gj) * rkj * s[i];
            if (w < 3) *(LAS float*)(L + GP_L + (ii * 64 + jj) * 4) = (ii > jj) ? e * bet[ii] * rk[ii] : 0.f;
            else *(bf16_t*)(rec + GR_A + ii * 144 + (jb * 32 + swz16(r)) * 2) = f2bf((ii >= jj) ? e * rq[ii] : 0.f); }
    }
    WG_BAR();
    if (w == 0) {
        const int hb = lane >> 5, cc = lane & 31; float tc[32];
        const LAS float* Lb = (const LAS float*)(L + GP_L) + (hb * 32) * 64 + hb * 32;
#pragma unroll
        for (int i = 0; i < 32; ++i) { float a0 = (i == cc) ? 1.f : 0.f, a1 = 0.f;
            if ((i & 3) == 0 && i > 0) { int zz; asm volatile("v_mov_b32 %0, 0" : "=v"(zz) : "v"(tc[i - 1])); Lb += zz; }
#pragma unroll
            for (int j4 = 0; j4 < i; j4 += 4) { const f32x4_t lv = *(const LAS f32x4_t*)(Lb + i * 64 + j4);
                a0 -= lv[0] * tc[j4]; if (j4 + 1 < i) a1 -= lv[1] * tc[j4 + 1]; if (j4 + 2 < i) a0 -= lv[2] * tc[j4 + 2]; if (j4 + 3 < i) a1 -= lv[3] * tc[j4 + 3]; }
            tc[i] = a0 + a1; }
        const float bu = bet[lane], bw = bu * rk[lane] * __expf(gcs[lane]);
#pragma unroll
        for (int i = 0; i < 32; ++i) { const int row = hb * 32 + i;
            *(LAS bf16_t*)(L + GP_TU + row * 144 + lane * 2) = f2bf(tc[i] * bu); *(LAS bf16_t*)(L + GP_TW + row * 144 + lane * 2) = f2bf(tc[i] * bw);
            if (hb == 1) { *(LAS bf16_t*)(L + GP_TU + i * 144 + lane * 2) = 0; *(LAS bf16_t*)(L + GP_TW + i * 144 + lane * 2) = 0; } }
        LAS unsigned char* T11t = L + GP_END; LAS unsigned char* T22r = L + GP_END + 4096;
        if (hb == 0) {
#pragma unroll
            for (int k8 = 0; k8 < 4; ++k8) *(LAS v4u*)(T11t + cc * 80 + k8 * 16) = mk4(pk2(tc[8 * k8], tc[8 * k8 + 1]), pk2(tc[8 * k8 + 2], tc[8 * k8 + 3]), pk2(tc[8 * k8 + 4], tc[8 * k8 + 5]), pk2(tc[8 * k8 + 6], tc[8 * k8 + 7])); }
        else {
#pragma unroll
            for (int i = 0; i < 32; ++i) *(LAS bf16_t*)(T22r + i * 80 + cc * 2) = f2bf(tc[i]); }
        asm volatile("s_waitcnt lgkmcnt(0)" ::: "memory");
        f32x16 X = zero16();
#pragma unroll
        for (int ks = 0; ks < 2; ++ks) { const LAS float* lp = (const LAS float*)(L + GP_L) + (32 + r) * 64 + ks * 16 + 8 * h;
            const f32x4_t l0 = *(const LAS f32x4_t*)lp, l1 = *(const LAS f32x4_t*)(lp + 4);
            const v4u av = mk4(pk2(l0[0], l0[1]), pk2(l0[2], l0[3]), pk2(l1[0], l1[1]), pk2(l1[2], l1[3]));
            X = MFMA32(__builtin_bit_cast(bf16x8, av), *(const LAS bf16x8*)(T11t + r * 80 + ks * 32 + h * 16), X); }
        f32x16 T21 = zero16();
#pragma unroll
        for (int sx = 0; sx < 2; ++sx) { const LAS unsigned char* ap = T22r + r * 80 + (16 * sx + 4 * h) * 2;
            const v2u a0 = *(const LAS v2u*)ap, a1 = *(const LAS v2u*)(ap + 16); v4u av; av.x = a0.x; av.y = a0.y; av.z = a1.x; av.w = a1.y;
            T21 = MFMA32(__builtin_bit_cast(bf16x8, av), pack_acc(X, sx), T21); }
        { const float bu2 = bet[r], bw2 = bu2 * rk[r] * __expf(gcs[r]);
#pragma unroll
          for (int i = 0; i < 16; ++i) { const int row = 32 + crow(i, h);
              *(LAS bf16_t*)(L + GP_TU + row * 144 + r * 2) = f2bf(-T21[i] * bu2); *(LAS bf16_t*)(L + GP_TW + row * 144 + r * 2) = f2bf(-T21[i] * bw2); } }
    }
    else {
        const int lt = tid - 64;
#pragma unroll 1
        for (int it = lt; it < 512; it += 448) { const int c = it >> 3, grp = it & 7;
            const u16x8 a0 = *(const LAS u16x8*)(L + GP_Q + c * 272 + grp * 32), a1 = *(const LAS u16x8*)(L + GP_Q + c * 272 + grp * 32 + 16); const float sc = rq[c] * __expf(gcs[c]);
            const v4u o0 = mk4(pk2(bf2f(a0[0]) * sc, bf2f(a0[1]) * sc), pk2(bf2f(a0[2]) * sc, bf2f(a0[3]) * sc), pk2(bf2f(a1[0]) * sc, bf2f(a1[1]) * sc), pk2(bf2f(a1[2]) * sc, bf2f(a1[3]) * sc));
            const v4u o1 = mk4(pk2(bf2f(a0[4]) * sc, bf2f(a0[5]) * sc), pk2(bf2f(a0[6]) * sc, bf2f(a0[7]) * sc), pk2(bf2f(a1[4]) * sc, bf2f(a1[5]) * sc), pk2(bf2f(a1[6]) * sc, bf2f(a1[7]) * sc));
            *(v4u*)(rec + GR_QD + c * 272 + grp * 32) = o0; *(v4u*)(rec + GR_QD + c * 272 + grp * 32 + 16) = o1; }
#pragma unroll 1
        for (int it = lt; it < 512; it += 448) { const int dk = it >> 2, grp = it & 3;
            const u16x8 a0 = *(const LAS u16x8*)(L + GP_KT + dk * 144 + grp * 32), a1 = *(const LAS u16x8*)(L + GP_KT + dk * 144 + grp * 32 + 16); float f[16];
#pragma unroll
            for (int j = 0; j < 8; ++j) { const int c0 = grp * 16 + j, c1 = c0 + 8; f[j] = bf2f(a0[j]) * rk[c0] * __expf(glast - gcs[c0]); f[8 + j] = bf2f(a1[j]) * rk[c1] * __expf(glast - gcs[c1]); }
            *(v4u*)(rec + GR_KDT + dk * 144 + grp * 32) = mk4(pk2(f[0], f[1]), pk2(f[2], f[3]), pk2(f[8], f[9]), pk2(f[10], f[11]));
            *(v4u*)(rec + GR_KDT + dk * 144 + grp * 32 + 16) = mk4(pk2(f[4], f[5]), pk2(f[6], f[7]), pk2(f[12], f[13]), pk2(f[14], f[15])); }
        if (lt == 0) *(float*)(rec + GR_W + 256) = __expf(glast);
    }
    WG_BAR();
    { const int cb = w >> 2, vs = w & 3; f32x16 u = zero16(), wn = zero16();
      mma_nt<4>(u, L + GP_TU + cb * 32 * 144, 144, L + GP_VT + vs * 32 * 144, 144, r, h);
      mma_nt<4>(wn, L + GP_TW + cb * 32 * 144, 144, L + GP_KT + vs * 32 * 144, 144, r, h);
#pragma unroll
      for (int i = 0; i < 16; ++i) { if ((i & 1) == 0) urec[((vs * 2 + cb) * 8 + (i >> 1)) * 64 + lane] = pk2(u[i], u[i + 1]);
          *(bf16_t*)(rec + GR_W + (cb * 32 + crow(i, h)) * 272 + (vs * 32 + swz16(r)) * 2) = f2bf(-wn[i]); } }
}
constexpr int GS_BUF = 0, GS_END = 2 * GREC;
__device__ __forceinline__ void gdn_dma(const unsigned char* src, LAS unsigned char* dst, int hw, int lane, bool full) {
#pragma unroll
    for (int p = 0; p < 16; ++p) { const int piece = hw + 4 * p; if (piece < GREC / 1024 && (full || piece < GR_QD / 1024 || (piece >= GR_KDT / 1024 && piece < GR_A / 1024)))
        __builtin_amdgcn_global_load_lds((const unsigned*)(src + (size_t)piece * 1024 + lane * 16), (LAS unsigned*)(dst + piece * 1024), 16, 0, 0); }
}
__device__ __forceinline__ void gdn_seq(const Params& P, int layer, int prob, LAS unsigned char* L, int tid_in, bool dry = false) {
    bf16_t* proj = (bf16_t*)(P.ws + WS_PROJ);
    const int seg = prob % NSG, bh = prob / NSG, b = bh >> 2, hd = bh & 3, w = __builtin_amdgcn_readfirstlane(tid_in >> 6);
    const int n_full = gseg_lo(seg), n_end = gseg_lo(seg + 1);
    const unsigned char* rec0 = P.ws + WS_GT + (size_t)(bh * 64) * GREC; const unsigned* urec0 = (const unsigned*)((unsigned char*)P.out + OUT_U) + (size_t)(bh * 64) * 4096;
    if (w >= 4) {
        const int ht = tid_in - 256; v4u RA[16], RB[16];
#define GDN_LD(R, chunk) do { const unsigned char* src_ = rec0 + (size_t)(chunk) * GREC; _Pragma("unroll") for (int q = 0; q < 16; ++q) { const int v = (q < 15) ? ht + 256 * q : min(ht + 3840, GREC / 16 - 1); \
            R[q] = *(const v4u*)(src_ + (size_t)v * 16); } } while (0)
#define GDN_ST(R, chunk) do { LAS unsigned char* dst_ = L + GS_BUF + ((chunk) & 1) * GREC; _Pragma("unroll") for (int q = 0; q < 16; ++q) { const int v = (q < 15) ? ht + 256 * q : min(ht + 3840, GREC / 16 - 1); \
            *(LAS v4u*)(dst_ + v * 16) = R[q]; } } while (0)
        const int last = n_end - 1;
        GDN_LD(RA, 0); GDN_LD(RB, min(1, last));
        GDN_ST(RA, 0); GDN_LD(RA, min(2, last));
        WG_BAR();
#pragma unroll 1
        for (int n = 0; n < n_end; n += 2) {
            GDN_ST(RB, n + 1);
            GDN_LD(RB, min(n + 3, last));
            WG_BAR();
            GDN_ST(RA, n + 2);
            GDN_LD(RA, min(n + 4, last));
            WG_BAR();
        }
#undef GDN_LD
#undef GDN_ST
        return;
    }
    f32x16 S[4];
#pragma unroll
    for (int k = 0; k < 4; ++k) S[k] = zero16();
    unsigned ur[16];
    { const int lane = tid_in & 63;
#pragma unroll
      for (int q = 0; q < 16; ++q) ur[q] = urec0[(w * 16 + q) * 64 + lane]; }
    WG_BAR();
#pragma unroll 1
    for (int n = 0; n < n_end; ++n) {
        int tid = tid_in; asm volatile("" : "+v"(tid));
        const int lane = tid & 63, r = lane & 31, h = lane >> 5; const bool full = (n >= n_full);
        {
            const int vs = w; const LAS unsigned char* Tt = L + GS_BUF + (n & 1) * GREC;
            f32x16 vn[2];
#pragma unroll
            for (int cb = 0; cb < 2; ++cb)
#pragma unroll
                for (int i = 0; i < 16; i += 2) { const unsigned uu = ur[cb * 8 + (i >> 1)]; vn[cb][i] = __uint_as_float(uu << 16); vn[cb][i + 1] = __uint_as_float(uu & 0xffff0000u); }
            if (n + 1 < n_end) { const unsigned* up = urec0 + (size_t)(n + 1) * 4096;
#pragma unroll
                for (int q = 0; q < 16; ++q) ur[q] = up[(vs * 16 + q) * 64 + lane]; }
            bf16x8 vb[2][2];
#define GDN_STATE() do { const float dec = *(const LAS float*)(Tt + GR_W + 256); \
            _Pragma("unroll") for (int kb = 0; kb < 4; ++kb) { S[kb] = S[kb] * dec; \
                _Pragma("unroll") for (int cb = 0; cb < 2; ++cb) \
                    _Pragma("unroll") for (int s = 0; s < 2; ++s) S[kb] = MFMA32(*(const LAS bf16x8*)(Tt + GR_KDT + (kb * 32 + r) * 144 + (cb * 32 + 16 * s + 8 * h) * 2), vb[cb][s], S[kb]); } } while (0)
            f32x16 o[2]; o[0] = zero16(); o[1] = zero16();
#pragma unroll
            for (int kb = 0; kb < 4; ++kb)
#pragma unroll
                for (int s = 0; s < 2; ++s) { const bf16x8 sb = pack_acc(S[kb], s);
#pragma unroll
                    for (int cb = 0; cb < 2; ++cb) { const int off = (cb * 32 + r) * 272 + (kb * 32 + 16 * s + 8 * h) * 2;
                        vn[cb] = MFMA32(*(const LAS bf16x8*)(Tt + GR_W + off), sb, vn[cb]);
                        if (full) o[cb] = MFMA32(sb, *(const LAS bf16x8*)(Tt + GR_QD + off), o[cb]); } }
#pragma unroll
            for (int cb = 0; cb < 2; ++cb)
#pragma unroll
                for (int s = 0; s < 2; ++s) vb[cb][s] = pack_acc(vn[cb], s);
            if (full) {
#pragma unroll
                for (int c2 = 0; c2 < 2; ++c2)
#pragma unroll
                    for (int cb = 0; cb <= c2; ++cb)
#pragma unroll
                        for (int s = 0; s < 2; ++s) o[c2] = MFMA32(vb[cb][s], *(const LAS bf16x8*)(Tt + GR_A + (c2 * 32 + r) * 144 + (cb * 32 + 16 * s + 8 * h) * 2), o[c2]);
            }
            GDN_STATE();
            if (!dry && full) store_cols_bf16(proj + ((size_t)b * SEQ + (size_t)n * 64 + r) * NP + C_GV + hd * 128 + vs * 32 + 4 * h, NP, o[0], o[1]);
#undef GDN_STATE
        }
        WG_BAR();
    }
}

__device__ __forceinline__ void mix_norm(const Params& P, int layer, int gw, int NGW, int lane) {
    bf16_t* proj = (bf16_t*)(P.ws + WS_PROJ);
    float nwr[8], nws[8], nwg[8];
#pragma unroll
    for (int j = 0; j < 8; ++j) { nwr[j] = P.ret_norm_w[layer * 512 + lane * 8 + j]; nws[j] = P.ssd_norm_w[layer * 512 + lane * 8 + j]; nwg[j] = P.gdn_norm_w[layer * 128 + (lane & 15) * 8 + j]; }
#pragma unroll 2
    for (int row = gw; row < T; row += NGW) { bf16_t* pr = proj + (size_t)row * NP + lane * 8;
        const bf16_t* ysr = (const bf16_t*)((unsigned char*)P.out + OUT_YS) + (size_t)row * 512 + lane * 8;
        const v4u yr = *(const v4u*)(pr + C_RQ), zr = *(const v4u*)(pr + C_RG), ys = *(const v4u*)ysr, zs = *(const v4u*)(pr + C_SZ), yg = *(const v4u*)(pr + C_GV), zg = *(const v4u*)(pr + C_GZ);
        float a[8], c[8], d[8], qa = 0.f, qc = 0.f, qd = 0.f;
#pragma unroll
        for (int j = 0; j < 8; ++j) { a[j] = bfsel(yr, j); qa += a[j] * a[j]; c[j] = bfsel(ys, j) * silu_f(bfsel(zs, j)); qc += c[j] * c[j]; d[j] = bfsel(yg, j); qd += d[j] * d[j]; }
#pragma unroll
        for (int o = 1; o < 16; o <<= 1) { qa += __shfl_xor(qa, o); qc += __shfl_xor(qc, o); qd += __shfl_xor(qd, o); }
        qc += __shfl_xor(qc, 16);
        const float ra = rsqrt_f(qa * (1.f / 128.f) + NORM_EPS), rc = rsqrt_f(qc * (1.f / 256.f) + NORM_EPS), rd = rsqrt_f(qd * (1.f / 128.f) + NORM_EPS);
#pragma unroll
        for (int j = 0; j < 8; ++j) { a[j] = a[j] * ra * nwr[j] * silu_f(bfsel(zr, j)); c[j] = c[j] * rc * nws[j]; d[j] = d[j] * rd * nwg[j] * silu_f(bfsel(zg, j)); }
        *(v4u*)(pr + C_RV) = mk4(pk2(a[0], a[1]), pk2(a[2], a[3]), pk2(a[4], a[5]), pk2(a[6], a[7]));
        *(v4u*)(pr + C_SX) = mk4(pk2(c[0], c[1]), pk2(c[2], c[3]), pk2(c[4], c[5]), pk2(c[6], c[7]));
        *(v4u*)(pr + C_GV) = mk4(pk2(d[0], d[1]), pk2(d[2], d[3]), pk2(d[4], d[5]), pk2(d[6], d[7])); }
}

struct Args { Params P; };
typedef const __attribute__((address_space(4))) Params* kparams_t;
__device__ __forceinline__ Params load_params() {
#if defined(__HIP_DEVICE_COMPILE__)
    kparams_t kp = (kparams_t)__builtin_amdgcn_kernarg_segment_ptr(); asm volatile("" : "+s"(kp));
    Params r; r.x = kp->x; r.pos = kp->pos; r.mix_norm_w = kp->mix_norm_w; r.w_in = kp->w_in; r.ret_norm_w = kp->ret_norm_w; r.ssd_conv_w = kp->ssd_conv_w; r.ssd_conv_b = kp->ssd_conv_b; r.ssd_dt_bias = kp->ssd_dt_bias;
    r.ssd_a_log = kp->ssd_a_log; r.ssd_d = kp->ssd_d; r.ssd_norm_w = kp->ssd_norm_w; r.gdn_conv_w = kp->gdn_conv_w; r.gdn_dt_bias = kp->gdn_dt_bias; r.gdn_a_log = kp->gdn_a_log; r.gdn_norm_w = kp->gdn_norm_w;
    r.w_out = kp->w_out; r.mlp_norm_w = kp->mlp_norm_w; r.w_up = kp->w_up; r.w_down = kp->w_down; r.final_norm_w = kp->final_norm_w; r.out = kp->out; r.ws = kp->ws; return r;
#else
    return Params{};
#endif
}

#define PHASE_FN __device__ __forceinline__ void
#define PHASE_PRO() extern __shared__ __attribute__((aligned(16))) unsigned char lds[]; LAS unsigned char* L = (LAS unsigned char*)lds; \
    int tid = threadIdx.x; asm volatile("" : "+v"(tid)); const int lane = tid & 63, wave = __builtin_amdgcn_readfirstlane(tid >> 6); const int G = gridDim.x, bx = blockIdx.x; \
    const int vcu = (G % 8 == 0) ? (bx % 8) * (G / 8) + bx / 8 : bx; const int gw = vcu * NWAVES + wave, NGW = G * NWAVES; LAS float* scr = (LAS float*)(L + RING_OFF + wave * 16384); \
    const Params P = load_params(); (void)lane; (void)gw; (void)NGW; (void)scr; (void)vcu; (void)L
#define ssa ((float*)(P.ws + WS_SSA))
#define ssb ((float*)(P.ws + WS_SSB))
#define sm ((float*)(P.ws + WS_SMALL))
#define xb ((bf16_t*)(P.ws + WS_XB))
#define proj ((bf16_t*)(P.ws + WS_PROJ))

PHASE_FN ph_grid_bar() {
    extern __shared__ __attribute__((aligned(16))) unsigned char lds[]; LAS unsigned char* L = (LAS unsigned char*)lds;
    XcdBarrier b_; b_.bar = (unsigned*)(load_params().ws + WS_CTL) + CW_BAR; b_.x = xb_xcc_id(); b_.st = (volatile LAS unsigned*)(L + MISC_OFF) + 8; xcd_barrier(b_);
}
PHASE_FN ph_p0() {
    PHASE_PRO();
    float* cs = (float*)(P.ws + WS_COS); float* sn = (float*)(P.ws + WS_SIN);
    const int gt = bx * (NWAVES * 64) + tid, ng = G * NWAVES * 64;
    for (int i = gt; i < T * 64; i += ng) {
        const int row = i >> 6, f = i & 63;
        const float inv = exp2f(-(float)f * (13.287712379549449f / 64.f));
        const float ang = (float)P.pos[row] * inv;
        double rev = (double)ang * 0.15915494309189535; rev -= floor(rev);
        const float r = (float)rev;
        cs[i] = __builtin_amdgcn_cosf(r); sn[i] = __builtin_amdgcn_sinf(r);
    }
#pragma unroll 1
    for (int row0 = gw; row0 < T; row0 += 4 * NGW) {
        float4 v[4][DM / 256];
#pragma unroll
        for (int i = 0; i < 4; ++i) { const float* xr = P.x + (size_t)min(row0 + i * NGW, T - 1) * DM;
#pragma unroll
            for (int j = 0; j < DM / 256; ++j) v[i][j] = *(const float4*)(xr + j * 256 + lane * 4); }
#pragma unroll
        for (int i = 0; i < 4; ++i) { const int row = row0 + i * NGW; float s = 0.f;
            if (row < T) {
#pragma unroll
                for (int j = 0; j < DM / 256; ++j) { const float4 q = v[i][j]; s += (q.x * q.x + q.y * q.y) + (q.z * q.z + q.w * q.w);
                    uint2 w; w.x = pk2(q.x, q.y); w.y = pk2(q.z, q.w); *(uint2*)(xb + (size_t)row * DM + j * 256 + lane * 4) = w; }
#pragma unroll
                for (int o = 1; o < 64; o <<= 1) s += __shfl_xor(s, o);
                if (lane < 16) ssb[(size_t)row * 16 + lane] = (lane == 0) ? s : 0.f; } }
    }
    convert_layer_weights(P, 0, scr, gw, NGW, lane, 1);
}
PHASE_FN ph_g1(int l) {
    PHASE_PRO(); unsigned char* wset = P.ws + WS_W + (size_t)(l & 1) * WSET;
    pg8::Gemm g{xb, (const bf16_t*)(wset + W_IN), T, NPX, DM, DM}; pg8::StaticOrder S; S.init(T, NPX, G, bx);
    pg8::EpiScaleBf16<0> E{proj, NP, ssb, (bf16_t*)(P.ws + WS_HALO), sm};
    pg8::gemm_phase<pg8::EpiScaleBf16<0>, pg8::StaticOrder, true, true>(L + RING_OFF, g, S, E);
}
PHASE_FN ph_m1(int l) {
    PHASE_PRO();
    { v4u R[11]; if (wave < 6) GDN_PREP_LD(R, bx, tid);
      ret_prep_rot(P, bx * (NWAVES * 64) + tid, G * NWAVES * 64);
      for (int task = bx; task < NB * 4 * 64; task += G) { gdn_prep(P, l, task, L, tid, R, (task + G < NB * 4 * 64) ? task + G : task); WG_BAR(); } }
    __syncthreads();
    for (int task = bx; task < NB * 2 * 64; task += 2 * G) { v4u RA[11], RB[11]; const bool two = task + G < NB * 2 * 64;
        SSD_PREP_LD(RA, task, tid); SSD_PREP_LD(RB, two ? task + G : task, tid);
        if (task == bx) {
            for (int vt = bx; vt < NB * 4 * 64; vt += 2 * G) { ret_prep_vt(P, vt, (vt + G < NB * 4 * 64) ? vt + G : -1, tid); __syncthreads(); } }
        ssd_prep(P, l, task, tid, RA); __syncthreads(); if (two) { ssd_prep(P, l, task + G, tid, RB); __syncthreads(); } }
}
PHASE_FN ph_m2_ret(int l) { PHASE_PRO(); ret_seq(P, l, bx, L, tid); }
PHASE_FN ph_m2_gdn(int l) { PHASE_PRO(); gdn_seq(P, l, bx - WG_RET, L, tid); }
PHASE_FN ph_m2_ssd(int l) { PHASE_PRO(); ssd_seq(P, l, bx - WG_RET - WG_GDN, L, tid); }
PHASE_FN ph_m3(int l) { PHASE_PRO(); mix_norm(P, l, gw, NGW, lane); }
PHASE_FN ph_m2_conv(int l) { PHASE_PRO(); if (l == 0) convert_layer_weights(P, 0, scr, (bx - WG_SEQ) * NWAVES + wave, (G - WG_SEQ) * NWAVES, lane, 2);
    if (l + 1 < DEPTH) convert_layer_weights(P, l + 1, scr, (bx - WG_SEQ) * NWAVES + wave, (G - WG_SEQ) * NWAVES, lane); }
PHASE_FN ph_g2(int l) {
    PHASE_PRO(); unsigned char* wset = P.ws + WS_W + (size_t)(l & 1) * WSET;
    pg8::Gemm g{proj + C_RV, (const bf16_t*)(wset + W_OUT), T, DM, MIXW, NP}; pg8::StaticOrder S; S.init(T, DM, G, bx);
    pg8::EpiRes E{xb, ssa};
    pg8::gemm_phase<pg8::EpiRes, pg8::StaticOrder, true, true>(L + RING_OFF, g, S, E);
}
PHASE_FN ph_g3(int l) {
    PHASE_PRO(); unsigned char* wset = P.ws + WS_W + (size_t)(l & 1) * WSET;
    pg8::Gemm g{xb, (const bf16_t*)(wset + W_UP), T, DFF, DM, DM}; pg8::StaticOrder S; S.init(T, DFF, G, bx);
    pg8::EpiScaleBf16<1> E{proj, DFF, ssa, nullptr, nullptr};
    pg8::gemm_phase<pg8::EpiScaleBf16<1>, pg8::StaticOrder, true, true>(L + RING_OFF, g, S, E);
}
PHASE_FN ph_g4(int l) {
    PHASE_PRO(); unsigned char* wset = P.ws + WS_W + (size_t)(l & 1) * WSET;
    pg8::Gemm g{proj, (const bf16_t*)(wset + W_DOWN), T, DM, DFF, DFF}; pg8::StaticOrder S; S.init(T, DM, G, bx);
    pg8::EpiRes E{xb, ssb};
    pg8::gemm_phase<pg8::EpiRes, pg8::StaticOrder, true, true>(L + RING_OFF, g, S, E);
}
PHASE_FN ph_final() {
    PHASE_PRO();
    float4 fw[DM / 256];
#pragma unroll
    for (int j = 0; j < DM / 256; ++j) fw[j] = *(const float4*)(P.final_norm_w + j * 256 + lane * 4);
#pragma unroll 1
    for (int row0 = gw; row0 < T; row0 += 4 * NGW) {
        uint2 q[4][DM / 256]; float rs[4];
#pragma unroll
        for (int i = 0; i < 4; ++i) { const int row = min(row0 + i * NGW, T - 1); rs[i] = row_rs(ssb, row); const bf16_t* xr = xb + (size_t)row * DM;
#pragma unroll
            for (int j = 0; j < DM / 256; ++j) q[i][j] = *(const uint2*)(xr + j * 256 + lane * 4); }
#pragma unroll
        for (int i = 0; i < 4; ++i) { const int row = row0 + i * NGW; if (row < T) { float* orow = P.out + (size_t)row * DM;
#pragma unroll
            for (int j = 0; j < DM / 256; ++j) { const float4 w = fw[j]; float4 v; v.x = __uint_as_float(q[i][j].x << 16) * rs[i] * w.x; v.y = __uint_as_float(q[i][j].x & 0xffff0000u) * rs[i] * w.y;
                v.z = __uint_as_float(q[i][j].y << 16) * rs[i] * w.z; v.w = __uint_as_float(q[i][j].y & 0xffff0000u) * rs[i] * w.w; *(float4*)(orow + j * 256 + lane * 4) = v; } } }
    }
}
#undef ssa
#undef ssb
#undef sm
#undef xb
#undef proj


__device__ __forceinline__ void layer_body(const int l, const int bx) {
    ph_g1(l); ph_grid_bar();
    ph_m1(l); ph_grid_bar();
    if (bx < WG_RET) ph_m2_ret(l); else if (bx < WG_RET + WG_GDN) ph_m2_gdn(l); else if (bx < WG_SEQ) ph_m2_ssd(l); else if (l + 1 < DEPTH || l == 0) ph_m2_conv(l);
    ph_grid_bar();
    ph_m3(l); ph_grid_bar();
    ph_g2(l); ph_grid_bar();
    ph_g3(l); ph_grid_bar();
    ph_g4(l); ph_grid_bar();
}
__global__ void __launch_bounds__(NWAVES * 64, 2) fwd_mega(Params Pk_unused) {
    extern __shared__ __attribute__((aligned(16))) unsigned char lds[];
    LAS unsigned char* L = (LAS unsigned char*)lds;
    for (int u = threadIdx.x; u < (LDS_BYTES - LDSCTL_OFF) / 4; u += NWAVES * 64) ((LAS unsigned*)(L + LDSCTL_OFF))[u] = 0u;
    __syncthreads();
    (void)xcd_barrier_post((unsigned*)(load_params().ws + WS_CTL) + CW_BAR, (volatile LAS unsigned*)(L + MISC_OFF) + 8);
    ph_p0();
    cg::this_grid().sync();
    const int bx = blockIdx.x;
    layer_body(0, bx); layer_body(1, bx); layer_body(2, bx); layer_body(3, bx);
    ph_final();
}

extern "C" void kernel_launch(void* const* d_in, const int* in_sizes, int n_in, void* d_out, int out_size, void* d_ws, size_t ws_size, hipStream_t stream) {
    static int grid = 0;
    if (grid == 0) {
        if (n_in != 20 || out_size != T * DM || ws_size < WS_END) { fprintf(stderr, "kernel_launch: unexpected shapes n_in=%d out=%d ws=%zu (need %zu)\n", n_in, out_size, ws_size, (size_t)WS_END); grid = -1; return; }
        int dev = 0, cus = 0, per_cu = 0;
        (void)hipGetDevice(&dev); (void)hipDeviceGetAttribute(&cus, hipDeviceAttributeMultiprocessorCount, dev);
        if (hipFuncSetAttribute((const void*)fwd_mega, hipFuncAttributeMaxDynamicSharedMemorySize, LDS_BYTES) != hipSuccess) { fprintf(stderr, "kernel_launch: hipFuncSetAttribute failed\n"); grid = -1; return; }
        if (hipOccupancyMaxActiveBlocksPerMultiprocessor(&per_cu, (const void*)fwd_mega, NWAVES * 64, LDS_BYTES) != hipSuccess || per_cu < 1) { fprintf(stderr, "kernel_launch: occupancy query says %d blocks/CU\n", per_cu); (void)hipGetLastError(); grid = -1; return; }
        grid = cus;
        if (grid % 8 != 0 || grid < 64) fprintf(stderr, "kernel_launch: note: %d CUs\n", grid);
    }
    if (grid < 0) return;
    Params P{};
    P.x = (const float*)d_in[0]; P.pos = (const int*)d_in[1]; P.mix_norm_w = (const float*)d_in[2]; P.w_in = (const float*)d_in[3]; P.ret_norm_w = (const float*)d_in[4];
    P.ssd_conv_w = (const float*)d_in[5]; P.ssd_conv_b = (const float*)d_in[6]; P.ssd_dt_bias = (const float*)d_in[7]; P.ssd_a_log = (const float*)d_in[8]; P.ssd_d = (const float*)d_in[9];
    P.ssd_norm_w = (const float*)d_in[10]; P.gdn_conv_w = (const float*)d_in[11]; P.gdn_dt_bias = (const float*)d_in[12]; P.gdn_a_log = (const float*)d_in[13]; P.gdn_norm_w = (const float*)d_in[14];
    P.w_out = (const float*)d_in[15]; P.mlp_norm_w = (const float*)d_in[16]; P.w_up = (const float*)d_in[17]; P.w_down = (const float*)d_in[18]; P.final_norm_w = (const float*)d_in[19];
    P.out = (float*)d_out; P.ws = (unsigned char*)d_ws;
    if (hipMemsetAsync((char*)d_ws + WS_CTL, 0, CTL_ZERO_BYTES, stream) != hipSuccess) { fprintf(stderr, "kernel_launch: memset failed\n"); return; }
    void* args[] = {&P};
    hipError_t e = hipLaunchCooperativeKernel((const void*)fwd_mega, dim3(grid), dim3(NWAVES * 64), args, LDS_BYTES, stream);
    if (e != hipSuccess) fprintf(stderr, "kernel_launch: cooperative launch failed: %s (grid %d)\n", hipGetErrorString(e), grid);
}
```
